# Optimizing an MI355X kernel written in HIP

```python
import jax, jax.numpy as jnp
from jax import lax
import numpy as np

D_MODEL = 1024
BATCH = 4
SEQ = 8192
DEPTH = 1

N_Q_HEADS = 16
N_KV_HEADS = 2
HEAD_DIM = 64
Q_PER_KV = N_Q_HEADS // N_KV_HEADS
WINDOW = 128
BLOCK = 128
ATTN_WIDTH = N_Q_HEADS * HEAD_DIM
KV_WIDTH = N_KV_HEADS * HEAD_DIM
POOL_WINDOWS = (2, 4, 8, 16)
N_POOL_GROUPS = len(POOL_WINDOWS)
POOL_WIDTH = 512
POOL_GROUP = POOL_WIDTH // N_POOL_GROUPS
D_FF = 2816
NORM_EPS = 1e-6
IN_SPLITS = tuple(int(s) for s in np.cumsum([ATTN_WIDTH, KV_WIDTH, KV_WIDTH, POOL_WIDTH, D_MODEL]))
IN_WIDTH = ATTN_WIDTH + 2 * KV_WIDTH + POOL_WIDTH + 2 * D_MODEL

kernel_name = "hybrid_swa_sink_alibi_pool_macaron"


def alibi_slopes():
    h = np.arange(1, N_Q_HEADS + 1, dtype=np.float32)
    return jnp.asarray(2.0 ** (-8.0 * h / N_Q_HEADS), dtype=jnp.float32).reshape(N_KV_HEADS, Q_PER_KV)


def rmsnorm(x, g):
    xf = x.astype(jnp.float32)
    y = xf * lax.rsqrt(jnp.mean(xf * xf, axis=-1, keepdims=True) + NORM_EPS)
    return (y * g.astype(jnp.float32)).astype(x.dtype)


def swiglu(x, w_up, w_down):
    a, b = jnp.split(x @ w_up, 2, axis=-1)
    return (jax.nn.silu(a) * b) @ w_down


def sliding_window_attention(q, k, v, sinks):
    B, S, _ = q.shape
    nb = S // BLOCK
    q = q.reshape(B, nb, BLOCK, N_KV_HEADS, Q_PER_KV, HEAD_DIM)
    k = k.reshape(B, S, N_KV_HEADS, HEAD_DIM)
    v = v.reshape(B, S, N_KV_HEADS, HEAD_DIM)
    pad = jnp.zeros((B, BLOCK, N_KV_HEADS, HEAD_DIM), k.dtype)

    def band(t):
        cur = t.reshape(B, nb, BLOCK, N_KV_HEADS, HEAD_DIM)
        prev = jnp.concatenate([pad, t[:, :S - BLOCK]], axis=1).reshape(B, nb, BLOCK, N_KV_HEADS, HEAD_DIM)
        return jnp.concatenate([prev, cur], axis=2)

    kb, vb = band(k), band(v)
    scale = HEAD_DIM ** -0.5
    scores = jnp.einsum('bnqhgd,bnkhd->bnhgqk', q, kb, preferred_element_type=jnp.float32) * scale
    qi = jnp.arange(BLOCK)[:, None] + BLOCK
    kj = jnp.arange(2 * BLOCK)[None, :]
    dist = (qi - kj)
    blk = jnp.arange(nb)[:, None, None]
    valid = (dist >= 0)[None] & (dist < WINDOW)[None] & (blk * BLOCK - BLOCK + kj[None] >= 0)
    slopes = alibi_slopes()[:, :, None, None]
    scores = scores - slopes * dist.astype(jnp.float32)
    scores = jnp.where(valid[None, :, None, None], scores, -jnp.inf)
    sink = sinks.astype(jnp.float32).reshape(N_KV_HEADS, Q_PER_KV)[:, :, None, None]
    m = jnp.maximum(jnp.max(scores, axis=-1, keepdims=True), sink)
    p = jnp.exp(scores - m)
    probs = p / (jnp.sum(p, axis=-1, keepdims=True) + jnp.exp(sink - m))
    out = jnp.einsum('bnhgqk,bnkhd->bnqhgd', probs.astype(vb.dtype), vb)
    return out.reshape(B, S, ATTN_WIDTH)


def multiscale_pool(z, w_mix, scale):
    B, S, _ = z.shape
    zf = z.astype(jnp.float32)
    c = jnp.concatenate([jnp.zeros((B, 1, POOL_WIDTH), jnp.float32), jnp.cumsum(zf, axis=1)], axis=1)
    t = jnp.arange(S)
    outs = []
    for gi, w in enumerate(POOL_WINDOWS):
        cg = c[:, :, gi * POOL_GROUP:(gi + 1) * POOL_GROUP]
        prev = jnp.concatenate([jnp.zeros((B, w - 1, POOL_GROUP), jnp.float32), cg[:, :S - w + 1]], axis=1)
        cnt = jnp.minimum(t + 1, w).astype(jnp.float32)[None, :, None]
        outs.append((cg[:, 1:] - prev) / cnt)
    pooled = (jnp.concatenate(outs, axis=-1) - zf).astype(z.dtype)
    pooled = pooled.reshape(B, S, N_POOL_GROUPS, POOL_GROUP)
    mixed = jnp.einsum('bsgc,gcd->bsgd', pooled, w_mix).reshape(B, S, POOL_WIDTH)
    return mixed * scale


def setup_inputs(seed: int = 0) -> dict:
    key = jax.random.key(seed)
    ks = jax.random.split(key, 20)
    f32 = jnp.float32

    def nrm(k, shape, fan_in):
        return jax.random.normal(k, shape, f32) * (fan_in ** -0.5)

    def gain(k, shape):
        return 1.0 + 0.02 * jax.random.normal(k, shape, f32)

    L = DEPTH
    return {
        "x": jax.random.normal(ks[0], (BATCH, SEQ, D_MODEL), f32),
        "ffn1_norm": gain(ks[1], (L, D_MODEL)),
        "ffn1_w_up": nrm(ks[2], (L, D_MODEL, 2 * D_FF), D_MODEL),
        "ffn1_w_down": nrm(ks[3], (L, D_FF, D_MODEL), D_FF),
        "mix_norm": gain(ks[4], (L, D_MODEL)),
        "w_in": nrm(ks[5], (L, D_MODEL, IN_WIDTH), D_MODEL),
        "sinks": jax.random.normal(ks[6], (L, N_Q_HEADS), f32),
        "w_attn_up": nrm(ks[7], (L, ATTN_WIDTH, D_MODEL), ATTN_WIDTH),
        "pool_w_mix": nrm(ks[8], (L, N_POOL_GROUPS, POOL_GROUP, POOL_GROUP), POOL_GROUP),
        "pool_scale": gain(ks[9], (L, POOL_WIDTH)),
        "w_pool_up": nrm(ks[10], (L, POOL_WIDTH, D_MODEL), POOL_WIDTH),
        "w_out": nrm(ks[11], (L, D_MODEL, D_MODEL), D_MODEL),
        "ffn2_norm": gain(ks[12], (L, D_MODEL)),
        "ffn2_w_up": nrm(ks[13], (L, D_MODEL, 2 * D_FF), D_MODEL),
        "ffn2_w_down": nrm(ks[14], (L, D_FF, D_MODEL), D_FF),
        "final_norm": gain(ks[15], (D_MODEL,)),
    }


def reference(x, ffn1_norm, ffn1_w_up, ffn1_w_down, mix_norm, w_in, sinks, w_attn_up,
              pool_w_mix, pool_scale, w_pool_up, w_out, ffn2_norm, ffn2_w_up, ffn2_w_down,
              final_norm):
    h = x
    for l in range(DEPTH):
        h = h + 0.5 * swiglu(rmsnorm(h, ffn1_norm[l]), ffn1_w_up[l], ffn1_w_down[l])
        u = rmsnorm(h, mix_norm[l])
        q, k, v, z, g_attn, g_pool = jnp.split(u @ w_in[l], IN_SPLITS, axis=-1)
        a = sliding_window_attention(q, k, v, sinks[l]) @ w_attn_up[l]
        p = multiscale_pool(z, pool_w_mix[l], pool_scale[l]) @ w_pool_up[l]
        merged = jax.nn.sigmoid(g_attn) * a + jax.nn.sigmoid(g_pool) * p
        h = h + merged @ w_out[l]
        h = h + 0.5 * swiglu(rmsnorm(h, ffn2_norm[l]), ffn2_w_up[l], ffn2_w_down[l])
    return rmsnorm(h, final_norm)
```

```cpp
#include <hip/hip_runtime.h>
#include <hip/hip_cooperative_groups.h>
#include <cstdio>
#include <cstdint>
namespace cg = cooperative_groups;
namespace pg8 {
#define PG8_LAS __attribute__((address_space(3)))
typedef unsigned short bf16_t;
typedef short bf16x8 __attribute__((ext_vector_type(8)));
typedef float f32x4 __attribute__((ext_vector_type(4)));
typedef unsigned u32x4 __attribute__((ext_vector_type(4)));
constexpr int BM = 256, BK = 64, HALF = 128, HTB = HALF * BK * 2  , STAGE_BYTES = 8 * HTB, NXCD = 8, WGM = 8;

__host__ __device__ __forceinline__ int lds_byte(int r, int c) { const int st = (r >> 4) * 2 + (c >> 5), rr = r & 15, cc = c & 31, ob = rr * 64 + cc * 2; return st * 1024 + (ob ^ (((ob >> 9) & 1) << 5)); }
__host__ __device__ __forceinline__ void stage_rc(int b, int& R, int& C) { const int st = b / 1024, sb = b % 1024, swz = sb ^ (((sb >> 9) & 1) << 5); R = (st >> 1) * 16 + swz / 64; C = (st & 1) * 32 + (swz % 64) / 2; }
__host__ __device__ __forceinline__ int perm32(int rho) { const int n = rho >> 4, i = rho & 15; return 8 * (i >> 2) + 4 * n + (i & 3); }

struct Unit { int pm, pn; };
struct Gemm { const bf16_t* A; const bf16_t* Bt; int M, N, K, lda, ldb; };

struct StaticOrder {
    int nM, nN, nwg, G, c;
    __host__ __device__ void init(int M, int N, int G_, int c_) { nM = M / BM; nN = N / BM; nwg = nM * nN; G = G_; c = c_; }
    __host__ __device__ bool next(int i, Unit& u) const {
        const long L = (long)i * G + c; if (L >= nwg) return false;
        int wgid = (int)L; { const int q = nwg / NXCD, r = nwg % NXCD, xcd = wgid % NXCD, off = wgid / NXCD; wgid = (xcd < r ? xcd * (q + 1) : r * (q + 1) + (xcd - r) * q) + off; }
        const int nig = WGM * nN, gid = wgid / nig, fm = gid * WGM, gsz = (nM - fm) < WGM ? (nM - fm) : WGM;
        u.pm = fm + ((wgid % nig) % gsz); u.pn = (wgid % nig) / gsz; return true;
    }
    __device__ __forceinline__ void a_ready(const Unit&) const {}
    __device__ __forceinline__ void done(const Unit&) const {}
};

__device__ __forceinline__ unsigned cvt_pk_bf16(float lo, float hi) { unsigned r; asm volatile("v_cvt_pk_bf16_f32 %0, %1, %2" : "=v"(r) : "v"(lo), "v"(hi)); return r; }
typedef unsigned u32x2 __attribute__((ext_vector_type(2)));
constexpr float LOG2E = 1.4426950408889634f;
__device__ __forceinline__ float rstd_of(float ssq) { return __builtin_amdgcn_rsqf(ssq * (1.0f / 1024.0f) + 1e-6f); }
__device__ __forceinline__ float sigmoid_f(float v) { return __builtin_amdgcn_rcpf(1.0f + __builtin_amdgcn_exp2f(-v * LOG2E)); }
__device__ __forceinline__ float bf_lo(unsigned w) { return __uint_as_float(w << 16); }
__device__ __forceinline__ float bf_hi(unsigned w) { return __uint_as_float(w & 0xffff0000u); }

struct EpiSwiglu {
    static constexpr bool PERM = true, AFTER_DRAIN = false;
    bf16_t* O; int ldc; const float* ssq;
    __device__ __forceinline__ void operator()(const f32x4 (&acc)[2][2][4][2], const Unit& u, int wr, int wc, int fr, int fq) const {
        const int row0 = u.pm * BM + wr * 64 + fr, col0 = u.pn * HALF + wc * 32 + 8 * fq;
#pragma unroll
        for (int ai = 0; ai < 2; ++ai)
#pragma unroll
            for (int m = 0; m < 4; ++m) { const int row = row0 + ai * HALF + m * 16; const float rs = rstd_of(ssq[row]);
                float o[8];
#pragma unroll
                for (int n = 0; n < 2; ++n)
#pragma unroll
                    for (int e = 0; e < 4; ++e) { const float a = acc[ai][0][m][n][e] * rs, b = acc[ai][1][m][n][e] * rs; o[4 * n + e] = a * sigmoid_f(a) * b; }
                u32x4 w; w.x = cvt_pk_bf16(o[0], o[1]); w.y = cvt_pk_bf16(o[2], o[3]); w.z = cvt_pk_bf16(o[4], o[5]); w.w = cvt_pk_bf16(o[6], o[7]);
                *(u32x4*)(O + (size_t)row * ldc + col0) = w; }
    }
};
struct EpiResid {
    static constexpr bool PERM = false, AFTER_DRAIN = false;
    const float* base; float* out; bf16_t* hb; float* ssq; float alpha;
    __device__ __forceinline__ void operator()(const f32x4 (&acc)[2][2][4][2], const Unit& u, int wr, int wc, int fr, int fq) const {
        const int row0 = u.pm * BM + wr * 64 + fr, col0 = u.pn * BM + wc * 32 + 4 * fq;
#pragma unroll
        for (int ai = 0; ai < 2; ++ai)
#pragma unroll
            for (int m = 0; m < 4; ++m) { const int row = row0 + ai * HALF + m * 16; const size_t off = (size_t)row * 1024 + col0; float s = 0.f;
#pragma unroll
                for (int bj = 0; bj < 2; ++bj)
#pragma unroll
                    for (int n = 0; n < 2; ++n) { const size_t o2 = off + bj * HALF + n * 16; const f32x4 bs = *(const f32x4*)(base + o2); const f32x4 o = bs + acc[ai][bj][m][n] * alpha;
                        *(f32x4*)(out + o2) = o; s += (o[0] * o[0] + o[1] * o[1]) + (o[2] * o[2] + o[3] * o[3]);
                        if (hb) { u32x2 w; w.x = cvt_pk_bf16(o[0], o[1]); w.y = cvt_pk_bf16(o[2], o[3]); *(u32x2*)(hb + o2) = w; } }
                s += __shfl_xor(s, 16); s += __shfl_xor(s, 32);
                if (ssq && fq == 0) atomicAdd(ssq + row, s); }
    }
};
struct EpiIn {
    static constexpr bool PERM = true, AFTER_DRAIN = false;
    bf16_t* O; const float* ssq; float qscale;
    __device__ __forceinline__ void operator()(const f32x4 (&acc)[2][2][4][2], const Unit& u, int wr, int wc, int fr, int fq) const {
        const int row0 = u.pm * BM + wr * 64 + fr, col0 = u.pn * BM + wc * 32 + 8 * fq;
        const bool sig = u.pn >= 7; const float sc = u.pn < 4 ? qscale : 1.f;
#pragma unroll
        for (int ai = 0; ai < 2; ++ai)
#pragma unroll
            for (int m = 0; m < 4; ++m) { const int row = row0 + ai * HALF + m * 16; const float rs = rstd_of(ssq[row]) * sc;
#pragma unroll
                for (int bj = 0; bj < 2; ++bj) { f32x4 v0 = acc[ai][bj][m][0] * rs, v1 = acc[ai][bj][m][1] * rs;
                    if (sig) {
#pragma unroll
                        for (int e = 0; e < 4; ++e) { v0[e] = sigmoid_f(v0[e]); v1[e] = sigmoid_f(v1[e]); } }
                    u32x4 w; w.x = cvt_pk_bf16(v0[0], v0[1]); w.y = cvt_pk_bf16(v0[2], v0[3]); w.z = cvt_pk_bf16(v1[0], v1[1]); w.w = cvt_pk_bf16(v1[2], v1[3]);
                    *(u32x4*)(O + (size_t)row * 3840 + col0 + bj * HALF) = w; } }
    }
};
template <bool ACCUM> struct EpiGate {
    static constexpr bool PERM = true, AFTER_DRAIN = false;
    const bf16_t* Gt; bf16_t* MG;
    __device__ __forceinline__ void operator()(const f32x4 (&acc)[2][2][4][2], const Unit& u, int wr, int wc, int fr, int fq) const {
        const int row0 = u.pm * BM + wr * 64 + fr, col0 = u.pn * BM + wc * 32 + 8 * fq;
#pragma unroll
        for (int ai = 0; ai < 2; ++ai)
#pragma unroll
            for (int m = 0; m < 4; ++m) { const int row = row0 + ai * HALF + m * 16;
#pragma unroll
                for (int bj = 0; bj < 2; ++bj) { const int col = col0 + bj * HALF; const u32x4 gw = *(const u32x4*)(Gt + (size_t)row * 3840 + col);
                    const f32x4 a0 = acc[ai][bj][m][0], a1 = acc[ai][bj][m][1];
                    float o[8] = { bf_lo(gw.x) * a0[0], bf_hi(gw.x) * a0[1], bf_lo(gw.y) * a0[2], bf_hi(gw.y) * a0[3], bf_lo(gw.z) * a1[0], bf_hi(gw.z) * a1[1], bf_lo(gw.w) * a1[2], bf_hi(gw.w) * a1[3] };
                    bf16_t* mp = MG + (size_t)row * 1024 + col;
                    if (ACCUM) { const u32x4 ow = *(const u32x4*)mp; o[0] += bf_lo(ow.x); o[1] += bf_hi(ow.x); o[2] += bf_lo(ow.y); o[3] += bf_hi(ow.y); o[4] += bf_lo(ow.z); o[5] += bf_hi(ow.z); o[6] += bf_lo(ow.w); o[7] += bf_hi(ow.w); }
                    u32x4 w; w.x = cvt_pk_bf16(o[0], o[1]); w.y = cvt_pk_bf16(o[2], o[3]); w.z = cvt_pk_bf16(o[4], o[5]); w.w = cvt_pk_bf16(o[6], o[7]);
                    *(u32x4*)mp = w; } }
    }
};
template <class Epi, class Sched, bool ALIGN_EPI = false, bool SP2 = false>
__device__ __forceinline__ void gemm_phase(PG8_LAS unsigned char* lds, const Gemm g, const Sched& S, const Epi& E) {
    const int tid = threadIdx.x, wid = __builtin_amdgcn_readfirstlane(tid >> 6), lane = tid & 63, wr = wid >> 2, wc = wid & 3, fr = lane & 15, fq = lane >> 4;
    const int K = g.K, nt = K / BK;
    unsigned voffA[2], voffB[2];
#pragma unroll
    for (int i = 0; i < 2; ++i) { int R, C; stage_rc(tid * 16 + i * 8192, R, C); const int Rb = Epi::PERM ? ((R & ~31) + perm32(R & 31)) : R;
        voffA[i] = (unsigned)(R * g.lda + C) * 2u; voffB[i] = (unsigned)(Rb * g.ldb + C) * 2u; }
    const size_t kstep = (size_t)(BK * 2);
    const size_t hstepA = (size_t)HALF * g.lda * 2, hstepB = (size_t)HALF * g.ldb * 2;
    const size_t tstepA = 2 * hstepA, tstepB = 2 * hstepB;
    const unsigned ldsw = (unsigned)wid * 1024u;
    const int aoff = lds_byte(wr * 64 + fr, fq * 8), boff = lds_byte(wc * 32 + fr, fq * 8);
#define PG8_SA(b, h) (((b) * 2 + (h)) * HTB)
#define PG8_SB(b, h) ((4 + (b) * 2 + (h)) * HTB)
#define PG8_STAGE(bufoff, gbase, voff) do { _Pragma("unroll") for (int _i = 0; _i < 2; ++_i) \
        __builtin_amdgcn_global_load_lds((const unsigned*)((const char*)(gbase) + (voff)[_i]), (PG8_LAS unsigned*)(lds + (bufoff) + ldsw + _i * 8192), 16, 0, 0); } while (0)
#define PG8_LDA(dst, b, h) do { _Pragma("unroll") for (int m = 0; m < 4; ++m) _Pragma("unroll") for (int k = 0; k < 2; ++k) dst[m][k] = *(const PG8_LAS bf16x8*)(lds + PG8_SA(b, h) + aoff + m * 2048 + k * 1024); } while (0)
#define PG8_LDB(dst, b, h) do { _Pragma("unroll") for (int n = 0; n < 2; ++n) _Pragma("unroll") for (int k = 0; k < 2; ++k) dst[n][k] = *(const PG8_LAS bf16x8*)(lds + PG8_SB(b, h) + boff + n * 2048 + k * 1024); } while (0)
#define PG8_MMA(ai, bj, At, Bt) do { __builtin_amdgcn_s_setprio(1); _Pragma("unroll") for (int m = 0; m < 4; ++m) _Pragma("unroll") for (int n = 0; n < 2; ++n) _Pragma("unroll") for (int k = 0; k < 2; ++k) \
        acc[ai][bj][m][n] = __builtin_amdgcn_mfma_f32_16x16x32_bf16(Bt[n][k], At[m][k], acc[ai][bj][m][n], 0, 0, 0); __builtin_amdgcn_s_setprio(0); } while (0)
#define PG8_WAIT_V(n) asm volatile("s_waitcnt vmcnt(" #n ")" ::: "memory")
#define PG8_WAIT_L(n) asm volatile("s_waitcnt lgkmcnt(" #n ")" ::: "memory")
#define PG8_BAR __builtin_amdgcn_s_barrier()
#define PG8_SCHED __builtin_amdgcn_sched_barrier(0)
    Unit cur, nxt; int ui = 0;
    if (!S.next(0, cur)) return;
    f32x4 acc[2][2][4][2];
#pragma unroll
    for (int a = 0; a < 2; ++a)
#pragma unroll
        for (int b = 0; b < 2; ++b)
#pragma unroll
            for (int m = 0; m < 4; ++m)
#pragma unroll
                for (int n = 0; n < 2; ++n) acc[a][b][m][n] = (f32x4){0.f, 0.f, 0.f, 0.f};
    bf16x8 At[4][2], B0[2][2], B1[2][2];
    const char* cA = (const char*)g.A + (size_t)cur.pm * tstepA; const char* cB = (const char*)g.Bt + (size_t)cur.pn * tstepB;
    S.a_ready(cur);
    if constexpr (SP2) {
        PG8_STAGE(PG8_SB(0, 0), cB, voffB); PG8_STAGE(PG8_SB(0, 1), cB + hstepB, voffB); PG8_STAGE(PG8_SA(0, 0), cA, voffA); PG8_STAGE(PG8_SA(0, 1), cA + hstepA, voffA);
        if (wr == 1) PG8_BAR;
        PG8_WAIT_V(2); PG8_BAR;
        PG8_STAGE(PG8_SB(1, 0), cB + kstep, voffB); PG8_STAGE(PG8_SA(1, 0), cA + kstep, voffA); PG8_STAGE(PG8_SB(1, 1), cB + hstepB + kstep, voffB);
        PG8_WAIT_V(6); PG8_BAR;
    } else {
        PG8_STAGE(PG8_SB(0, 0), cB, voffB); PG8_STAGE(PG8_SA(0, 0), cA, voffA); PG8_STAGE(PG8_SB(0, 1), cB + hstepB, voffB); PG8_STAGE(PG8_SA(0, 1), cA + hstepA, voffA);
        if (wr == 1) PG8_BAR;
        PG8_WAIT_V(4); PG8_BAR;
        PG8_STAGE(PG8_SB(1, 0), cB + kstep, voffB); PG8_STAGE(PG8_SA(1, 0), cA + kstep, voffA); PG8_STAGE(PG8_SB(1, 1), cB + hstepB + kstep, voffB);
        PG8_WAIT_V(6); PG8_BAR;
    }
    for (;;) {
        const bool has_next = S.next(ui + 1, nxt);
        const char* nA = has_next ? (const char*)g.A + (size_t)nxt.pm * tstepA : cA; const char* nB = has_next ? (const char*)g.Bt + (size_t)nxt.pn * tstepB : cB;
        for (int t = 0; t < nt; t += 2) {
            const bool last = (t == nt - 2);
            const char* a1 = cA + (size_t)(t + 1) * kstep;
            const char* a2 = last ? nA : cA + (size_t)(t + 2) * kstep; const char* b2 = last ? nB : cB + (size_t)(t + 2) * kstep;
            const char* a3 = a2 + kstep; const char* b3 = b2 + kstep;
            if (last && has_next) S.a_ready(nxt);
            if constexpr (SP2) {
            PG8_LDB(B0, 0, 0); PG8_LDB(B1, 0, 1); PG8_SCHED; PG8_LDA(At, 0, 0); PG8_STAGE(PG8_SA(1, 1), a1 + hstepA, voffA);
            PG8_WAIT_V(8); PG8_WAIT_L(0); PG8_BAR; PG8_MMA(0, 0, At, B0); PG8_MMA(0, 1, At, B1); PG8_BAR; PG8_SCHED;
            PG8_LDA(At, 0, 1); PG8_STAGE(PG8_SB(0, 0), b2, voffB); PG8_STAGE(PG8_SB(0, 1), b2 + hstepB, voffB); PG8_STAGE(PG8_SA(0, 0), a2, voffA);
            PG8_WAIT_V(8); PG8_WAIT_L(0); PG8_BAR; PG8_MMA(1, 0, At, B0); PG8_MMA(1, 1, At, B1); PG8_BAR; PG8_SCHED;
            PG8_LDB(B0, 1, 0); PG8_LDB(B1, 1, 1); PG8_SCHED; PG8_LDA(At, 1, 0); PG8_STAGE(PG8_SA(0, 1), a2 + hstepA, voffA);
            PG8_WAIT_V(8); PG8_WAIT_L(0); PG8_BAR; PG8_MMA(0, 0, At, B0); PG8_MMA(0, 1, At, B1); PG8_BAR; PG8_SCHED;
            PG8_LDA(At, 1, 1); PG8_STAGE(PG8_SB(1, 0), b3, voffB); PG8_STAGE(PG8_SB(1, 1), b3 + hstepB, voffB); PG8_STAGE(PG8_SA(1, 0), a3, voffA);
            PG8_WAIT_V(8); PG8_WAIT_L(0); PG8_BAR; PG8_MMA(1, 0, At, B0); PG8_MMA(1, 1, At, B1); PG8_BAR; PG8_SCHED;
            } else {
            PG8_LDB(B0, 0, 0); PG8_SCHED; PG8_LDA(At, 0, 0); PG8_STAGE(PG8_SA(1, 1), a1 + hstepA, voffA);
            PG8_WAIT_L(8); PG8_BAR; PG8_WAIT_L(0); PG8_MMA(0, 0, At, B0); PG8_BAR; PG8_SCHED;
            PG8_LDB(B1, 0, 1); PG8_STAGE(PG8_SB(0, 0), b2, voffB);
            PG8_BAR; PG8_WAIT_L(0); PG8_MMA(0, 1, At, B1); PG8_BAR;
            PG8_LDA(At, 0, 1); PG8_STAGE(PG8_SA(0, 0), a2, voffA);
            PG8_BAR; PG8_WAIT_L(0); PG8_MMA(1, 0, At, B0); PG8_BAR; PG8_SCHED;
            PG8_STAGE(PG8_SB(0, 1), b2 + hstepB, voffB);
            PG8_WAIT_V(6); PG8_BAR; PG8_MMA(1, 1, At, B1); PG8_BAR;
            PG8_LDB(B0, 1, 0); PG8_SCHED; PG8_LDA(At, 1, 0); PG8_STAGE(PG8_SA(0, 1), a2 + hstepA, voffA);
            PG8_WAIT_L(8); PG8_BAR; PG8_WAIT_L(0); PG8_MMA(0, 0, At, B0); PG8_BAR; PG8_SCHED;
            PG8_LDB(B1, 1, 1); PG8_STAGE(PG8_SB(1, 0), b3, voffB);
            PG8_BAR; PG8_WAIT_L(0); PG8_MMA(0, 1, At, B1); PG8_BAR;
            PG8_LDA(At, 1, 1); PG8_STAGE(PG8_SA(1, 0), a3, voffA);
            PG8_BAR; PG8_WAIT_L(0); PG8_MMA(1, 0, At, B0); PG8_BAR; PG8_SCHED;
            PG8_STAGE(PG8_SB(1, 1), b3 + hstepB, voffB);
            PG8_WAIT_V(6); PG8_BAR; PG8_MMA(1, 1, At, B1); PG8_BAR;
            }
        }
        if constexpr (ALIGN_EPI) { if (wr == 0) PG8_BAR; }
        if constexpr (!Epi::AFTER_DRAIN) { E(acc, cur, wr, wc, fr, fq); S.done(cur); }
        if (!has_next) break;
#pragma unroll
        for (int a = 0; a < 2; ++a)
#pragma unroll
            for (int b = 0; b < 2; ++b)
#pragma unroll
                for (int m = 0; m < 4; ++m)
#pragma unroll
                    for (int n = 0; n < 2; ++n) acc[a][b][m][n] = (f32x4){0.f, 0.f, 0.f, 0.f};
        cur = nxt; cA = nA; cB = nB; ++ui;
        if constexpr (ALIGN_EPI) { if (wr == 1) PG8_BAR; }
    }
    PG8_WAIT_V(0);
    if constexpr (!ALIGN_EPI) { if (wr == 0) PG8_BAR; }
    PG8_BAR;
    if constexpr (Epi::AFTER_DRAIN) { E.fused(acc, cur, wr, wc, fr, fq, lds, wid, lane); S.done(cur); }
#undef PG8_SA
#undef PG8_SB
#undef PG8_STAGE
#undef PG8_LDA
#undef PG8_LDB
#undef PG8_MMA
#undef PG8_WAIT_V
#undef PG8_WAIT_L
#undef PG8_BAR
#undef PG8_SCHED
}
}
#define LAS __attribute__((address_space(3)))
typedef unsigned short bf16;
typedef unsigned u32x4 __attribute__((ext_vector_type(4)));
typedef unsigned u32x2 __attribute__((ext_vector_type(2)));
typedef float f32x4 __attribute__((ext_vector_type(4)));
typedef float f32x16 __attribute__((ext_vector_type(16)));
typedef short bf16x8 __attribute__((ext_vector_type(8)));
constexpr int NWAVES = 8, NTHR = 512;
constexpr int BATCH = 4, SEQ = 8192, D = 1024, M = BATCH * SEQ, DFF = 2816, NUP = 2 * DFF, NIN = 3840, PW = 512;
constexpr int COL_K = 1024, COL_V = 1152, COL_Z = 1280, COL_GA = 1792, COL_GP = 2816;
constexpr float LOG2E = 1.4426950408889634f;
constexpr size_t MiB = 1u << 20;
constexpr size_t WS_SSQ = 0;
constexpr size_t WS_WUP1 = 1 * MiB, WS_WDN1 = 12 * MiB, WS_WIN = 18 * MiB, WS_WATT = 26 * MiB, WS_WEFF = 28 * MiB, WS_WOUT = 29 * MiB, WS_WUP2 = 31 * MiB, WS_WDN2 = 42 * MiB;
constexpr size_t WS_HB = 48 * MiB;
constexpr size_t WS_R1 = 112 * MiB;
constexpr size_t WS_PL = 352 * MiB;
constexpr size_t WS_MG = 384 * MiB;
constexpr size_t WS_END = 448 * MiB;
constexpr int LDS_BYTES = 147456;
constexpr int NPHASE = 10;
#ifndef MK_N_LAUNCHES
#define MK_N_LAUNCHES 1
#endif

__device__ __forceinline__ unsigned f2bf(float f) { unsigned u = __builtin_bit_cast(unsigned, f); return (u + 0x7fffu + ((u >> 16) & 1u)) >> 16; }
__device__ __forceinline__ unsigned pk2(float lo, float hi) { return f2bf(lo) | (f2bf(hi) << 16); }
__device__ __forceinline__ float bf2f(bf16 v) { return __uint_as_float((unsigned)v << 16); }
__device__ __forceinline__ float wave_sum(float v) {
#pragma unroll
    for (int o = 1; o < 64; o <<= 1) v += __shfl_xor(v, o);
    return v;
}
__device__ __forceinline__ void transpose_item(const float* W, int K, int N, bf16* WT, const float* gain, bool swiglu, LAS float* scr, int item, int lane) {
    const int nblk = N / 32, kb = item / nblk, nb = item % nblk, k0 = 64 * kb, n0 = 32 * nb;
    int dr = n0;
    if (swiglu) { if (n0 < DFF) dr = 256 * (n0 / 128) + (n0 % 128); else { const int j = n0 - DFF; dr = 256 * (j / 128) + 128 + (j % 128); } }
#pragma unroll 8
    for (int i = 0; i < 32; ++i) { const int kk = 2 * i + (lane >> 5); float v = W[(size_t)(k0 + kk) * N + n0 + (lane & 31)]; if (gain) v *= gain[k0 + kk]; scr[kk * 33 + (lane & 31)] = v; }
    asm volatile("s_waitcnt lgkmcnt(0)" ::: "memory");
    const int c = lane & 7;
#pragma unroll
    for (int j = 0; j < 4; ++j) { const int n = (lane >> 3) + 8 * j; const LAS float* s = scr + (8 * c) * 33 + n;
        u32x4 o; o.x = pk2(s[0 * 33], s[1 * 33]); o.y = pk2(s[2 * 33], s[3 * 33]); o.z = pk2(s[4 * 33], s[5 * 33]); o.w = pk2(s[6 * 33], s[7 * 33]);
        *(u32x4*)(WT + (size_t)(dr + n) * K + k0 + 8 * c) = o; }
    asm volatile("s_waitcnt lgkmcnt(0)" ::: "memory");
}

struct Args { const float* in[16]; float* out; unsigned char* ws; int ph_lo, ph_hi; };

constexpr int KROWB = 144, VROWB = 520, LDS_VT = 256 * KROWB;
__device__ __forceinline__ void attn_pool_phase(LAS unsigned char* lds, bf16* QKV, bf16* PL, const float* sinks, int G, int bid) {
    const int tid = threadIdx.x, lane = tid & 63, wid = __builtin_amdgcn_readfirstlane(tid >> 6), q = lane & 31, hi = lane >> 5;
    for (int unit = bid; unit < BATCH * 64 * 2; unit += G) {
        const int hk = unit & 1, n = (unit >> 1) & 63, b = unit >> 7;
        const size_t rowbase = (size_t)b * SEQ; const int kpos0 = (n - 1) * 128;
#pragma unroll
        for (int i = 0; i < 4; ++i) { const int id = tid + NTHR * i, r = id >> 3, c = id & 7, pos = kpos0 + r;
            u32x4 kv = (u32x4){0u, 0u, 0u, 0u}, vv = (u32x4){0u, 0u, 0u, 0u};
            if (pos >= 0) { const bf16* p = QKV + (rowbase + pos) * NIN + COL_K + hk * 64 + c * 8; kv = *(const u32x4*)p; vv = *(const u32x4*)(p + 128); }
            *(LAS u32x4*)(lds + r * KROWB + c * 16) = kv;
            LAS unsigned short* vt = (LAS unsigned short*)(lds + LDS_VT) + (c * 8) * (VROWB / 2) + r;
            vt[0 * (VROWB / 2)] = (unsigned short)(vv.x & 0xffffu); vt[1 * (VROWB / 2)] = (unsigned short)(vv.x >> 16);
            vt[2 * (VROWB / 2)] = (unsigned short)(vv.y & 0xffffu); vt[3 * (VROWB / 2)] = (unsigned short)(vv.y >> 16);
            vt[4 * (VROWB / 2)] = (unsigned short)(vv.z & 0xffffu); vt[5 * (VROWB / 2)] = (unsigned short)(vv.z >> 16);
            vt[6 * (VROWB / 2)] = (unsigned short)(vv.w & 0xffffu); vt[7 * (VROWB / 2)] = (unsigned short)(vv.w >> 16); }
        __syncthreads();
        const int h = hk * 8 + wid;
        const float slopeL = __builtin_bit_cast(float, __builtin_amdgcn_readfirstlane(__builtin_bit_cast(int, __builtin_amdgcn_exp2f(-0.5f * (float)(h + 1)) * LOG2E))), sink2 = sinks[h] * LOG2E;
        for (int i = 0; i < 4; ++i) {
            bf16* qp = QKV + (rowbase + n * 128 + 32 * i + q) * NIN + h * 64;
            bf16x8 qf[4];
#pragma unroll
            for (int d0 = 0; d0 < 4; ++d0) qf[d0] = *(const bf16x8*)(qp + d0 * 16 + 8 * hi);
            f32x16 S[5];
#pragma unroll
            for (int j = 0; j < 5; ++j) { const LAS unsigned char* kp = lds + (32 * (i + j) + q) * KROWB + hi * 16;
                f32x16 a = {};
#pragma unroll
                for (int d0 = 0; d0 < 4; ++d0) a = __builtin_amdgcn_mfma_f32_32x32x16_bf16(*(const LAS bf16x8*)(kp + d0 * 32), qf[d0], a, 0, 0, 0);
                S[j] = a; }
            float mx = sink2;
            int qo = q - 4 * hi; asm volatile("" : "+v"(qo));
            const float lb = -slopeL * (float)(128 + qo);
#pragma unroll
            for (int j = 0; j < 5; ++j) { const bool tile_ok = !(n == 0 && i + j < 4); const float lbj = lb + slopeL * (32.0f * (float)j);
#pragma unroll
                for (int r = 0; r < 16; ++r) { const int crc = (r & 3) + 8 * (r >> 2);
                    float s = S[j][r] + (lbj + slopeL * (float)crc);
                    if (j == 0) s = (crc > qo) ? s : -INFINITY;
                    if (j == 4) s = (crc <= qo) ? s : -INFINITY;
                    if (!tile_ok) s = -INFINITY;
                    S[j][r] = s; mx = fmaxf(mx, s); } }
            mx = fmaxf(mx, __shfl_xor(mx, 32));
            float l = 0.f;
#pragma unroll
            for (int j = 0; j < 5; ++j)
#pragma unroll
                for (int r = 0; r < 16; ++r) { const float p = __builtin_amdgcn_exp2f(S[j][r] - mx); S[j][r] = p; l += p; }
            l += __shfl_xor(l, 32); l += __builtin_amdgcn_exp2f(sink2 - mx);
            f32x16 o0 = {}, o1 = {};
#pragma unroll
            for (int j = 0; j < 5; ++j)
#pragma unroll
                for (int c = 0; c < 2; ++c) {
                    u32x4 pw; pw.x = pg8::cvt_pk_bf16(S[j][8 * c + 0], S[j][8 * c + 1]); pw.y = pg8::cvt_pk_bf16(S[j][8 * c + 2], S[j][8 * c + 3]);
                    pw.z = pg8::cvt_pk_bf16(S[j][8 * c + 4], S[j][8 * c + 5]); pw.w = pg8::cvt_pk_bf16(S[j][8 * c + 6], S[j][8 * c + 7]);
                    const bf16x8 pb = __builtin_bit_cast(bf16x8, pw);
                    const LAS unsigned char* vp = lds + LDS_VT + q * VROWB + (32 * (i + j) + 16 * c + 4 * hi) * 2;
                    const u32x2 a0 = *(const LAS u32x2*)vp, a1 = *(const LAS u32x2*)(vp + 16), b0 = *(const LAS u32x2*)(vp + 32 * VROWB), b1 = *(const LAS u32x2*)(vp + 32 * VROWB + 16);
                    const bf16x8 va = __builtin_bit_cast(bf16x8, (u32x4){a0.x, a0.y, a1.x, a1.y}), vb = __builtin_bit_cast(bf16x8, (u32x4){b0.x, b0.y, b1.x, b1.y});
                    o0 = __builtin_amdgcn_mfma_f32_32x32x16_bf16(va, pb, o0, 0, 0, 0);
                    o1 = __builtin_amdgcn_mfma_f32_32x32x16_bf16(vb, pb, o1, 0, 0, 0); }
            const float inv = 1.0f / l;
#pragma unroll
            for (int rg = 0; rg < 4; ++rg) { const int d = 8 * rg + 4 * hi;
                u32x2 w0, w1; w0.x = pg8::cvt_pk_bf16(o0[4 * rg] * inv, o0[4 * rg + 1] * inv); w0.y = pg8::cvt_pk_bf16(o0[4 * rg + 2] * inv, o0[4 * rg + 3] * inv);
                w1.x = pg8::cvt_pk_bf16(o1[4 * rg] * inv, o1[4 * rg + 1] * inv); w1.y = pg8::cvt_pk_bf16(o1[4 * rg + 2] * inv, o1[4 * rg + 3] * inv);
                *(u32x2*)(qp + d) = w0; *(u32x2*)(qp + 32 + d) = w1; }
        }
        __syncthreads();
    }
    for (int item = bid; item < M / 64; item += G) {
        const int row0 = item * 64, t0 = row0 & (SEQ - 1), c = tid, w = 2 << (c >> 7);
        const bf16* zp = QKV + (size_t)row0 * NIN + COL_Z + c;
        float s = 0.f;
        for (int j = 1; j < w; ++j) if (t0 - j >= 0) s += bf2f(zp[-(long)j * NIN]);
        const float invw = 1.0f / (float)w;
#pragma unroll 4
        for (int tt = 0; tt < 64; ++tt) { const float z = bf2f(zp[(long)tt * NIN]); s += z; const int t = t0 + tt;
            const float o = s * (t + 1 >= w ? invw : 1.0f / (float)(t + 1)) - z;
            PL[(size_t)(row0 + tt) * PW + c] = (bf16)f2bf(o);
            if (t - w + 1 >= 0) s -= bf2f(zp[(long)(tt - w + 1) * NIN]); }
    }
}

__global__ void __launch_bounds__(NTHR, 2) mk_fwd(Args args) {
    extern __shared__ __attribute__((aligned(16))) unsigned char lds_raw[];
    LAS unsigned char* lds = (LAS unsigned char*)lds_raw;
    cg::grid_group grid = cg::this_grid();
    const int tid = threadIdx.x, lane = tid & 63, wave = __builtin_amdgcn_readfirstlane(tid >> 6);
    const int G = gridDim.x, bid = blockIdx.x;
    const int lo = args.ph_lo, hi = args.ph_hi;
    unsigned char* ws = args.ws;
    const float* x = args.in[0]; float* out = args.out;
    float* ssq1 = (float*)(ws + WS_SSQ); float* ssq2 = ssq1 + M; float* ssq3 = ssq2 + M; float* ssq4 = ssq3 + M;
    bf16* Wup1 = (bf16*)(ws + WS_WUP1); bf16* Wdn1 = (bf16*)(ws + WS_WDN1); bf16* Win = (bf16*)(ws + WS_WIN); bf16* Watt = (bf16*)(ws + WS_WATT);
    bf16* Weff = (bf16*)(ws + WS_WEFF); bf16* Wout = (bf16*)(ws + WS_WOUT); bf16* Wup2 = (bf16*)(ws + WS_WUP2); bf16* Wdn2 = (bf16*)(ws + WS_WDN2);
    bf16* HB = (bf16*)(ws + WS_HB); bf16* R1 = (bf16*)(ws + WS_R1); bf16* PL = (bf16*)(ws + WS_PL); bf16* MG = (bf16*)(ws + WS_MG);
#ifdef MK_ONLY
#define IN(k) ((k) == MK_ONLY && lo <= (k) && (k) < hi)
#else
#define IN(k) (lo <= (k) && (k) < hi)
#endif
#define SEAM(k) do { if (IN(k) && IN((k) + 1)) grid.sync(); } while (0)

    if (IN(0)) {
        LAS float* scr = (LAS float*)(lds + wave * 16384);
        const int gw = bid * NWAVES + wave, NGW = G * NWAVES;
        constexpr int I_UP = (D / 64) * (NUP / 32), I_DN = (DFF / 64) * (D / 32), I_IN = (D / 64) * (NIN / 32), I_SQ = (D / 64) * (D / 32);
        constexpr int NITEMS = 2 * I_UP + 2 * I_DN + I_IN + 2 * I_SQ;
        for (int it = gw; it < NITEMS; it += NGW) {
            int r = it;
            if (r < I_UP) { transpose_item(args.in[2], D, NUP, Wup1, args.in[1], true, scr, r, lane); continue; } r -= I_UP;
            if (r < I_UP) { transpose_item(args.in[13], D, NUP, Wup2, args.in[12], true, scr, r, lane); continue; } r -= I_UP;
            if (r < I_DN) { transpose_item(args.in[3], DFF, D, Wdn1, nullptr, false, scr, r, lane); continue; } r -= I_DN;
            if (r < I_DN) { transpose_item(args.in[14], DFF, D, Wdn2, nullptr, false, scr, r, lane); continue; } r -= I_DN;
            if (r < I_IN) { transpose_item(args.in[5], D, NIN, Win, args.in[4], false, scr, r, lane); continue; } r -= I_IN;
            if (r < I_SQ) { transpose_item(args.in[7], D, D, Watt, nullptr, false, scr, r, lane); continue; } r -= I_SQ;
            transpose_item(args.in[11], D, D, Wout, nullptr, false, scr, r, lane);
        }
        { const float* wmix = args.in[8]; const float* pscale = args.in[9]; const float* wpool = args.in[10];
          for (int idx = bid * NTHR + tid; idx < PW * D; idx += G * NTHR) { const int k = idx >> 10, n = idx & 1023, g = k >> 7;
              const float* wm = wmix + (size_t)k * 128; const float* sc = pscale + g * 128; const float* wp = wpool + (size_t)(g * 128) * D + n; float s = 0.f;
#pragma unroll 8
              for (int c = 0; c < 128; ++c) s += wm[c] * sc[c] * wp[(size_t)c * D];
              Weff[(size_t)n * PW + k] = (bf16)f2bf(s); } }
        for (int m = gw; m < M; m += NGW) { const f32x4* xr = (const f32x4*)(x + (size_t)m * D) + lane; float s = 0.f; unsigned long long* o8 = (unsigned long long*)(HB + (size_t)m * D) + lane;
#pragma unroll
            for (int j = 0; j < 4; ++j) { const f32x4 v = xr[64 * j]; s += (v.x * v.x + v.y * v.y) + (v.z * v.z + v.w * v.w); o8[64 * j] = (unsigned long long)pk2(v.x, v.y) | ((unsigned long long)pk2(v.z, v.w) << 32); }
            s = wave_sum(s); if (lane == 0) ssq1[m] = s; }
        for (int idx = bid * NTHR + tid; idx < 3 * M; idx += G * NTHR) ssq2[idx] = 0.f;
    }
    SEAM(0);
    if (IN(1)) { pg8::Gemm g{HB, Wup1, M, NUP, D, D, D}; pg8::StaticOrder S; S.init(M, NUP, G, bid); pg8::EpiSwiglu E{R1, DFF, ssq1};
        pg8::gemm_phase<pg8::EpiSwiglu, pg8::StaticOrder, true, true>(lds, g, S, E); }
    SEAM(1);
    if (IN(2)) { pg8::Gemm g{R1, Wdn1, M, D, DFF, DFF, DFF}; pg8::StaticOrder S; S.init(M, D, G, bid); pg8::EpiResid E{x, out, HB, ssq2, 0.5f};
        pg8::gemm_phase<pg8::EpiResid, pg8::StaticOrder, true, true>(lds, g, S, E); }
    SEAM(2);
    if (IN(3)) { pg8::Gemm g{HB, Win, M, NIN, D, D, D}; pg8::StaticOrder S; S.init(M, NIN, G, bid); pg8::EpiIn E{R1, ssq2, 0.125f * LOG2E};
        pg8::gemm_phase<pg8::EpiIn, pg8::StaticOrder, true, true>(lds, g, S, E); }
    SEAM(3);
    if (IN(4)) attn_pool_phase(lds, R1, PL, args.in[6], G, bid);
    SEAM(4);
    if (IN(5)) {
        { pg8::Gemm g{R1, Watt, M, D, D, NIN, D}; pg8::StaticOrder S; S.init(M, D, G, bid); pg8::EpiGate<false> E{R1 + COL_GA, MG};
          pg8::gemm_phase<pg8::EpiGate<false>, pg8::StaticOrder, true, true>(lds, g, S, E); }
        { pg8::Gemm g{PL, Weff, M, D, PW, PW, PW}; pg8::StaticOrder S; S.init(M, D, G, bid); pg8::EpiGate<true> E{R1 + COL_GP, MG};
          pg8::gemm_phase<pg8::EpiGate<true>, pg8::StaticOrder, true, true>(lds, g, S, E); }
    }
    SEAM(5);
    if (IN(6)) { pg8::Gemm g{MG, Wout, M, D, D, D, D}; pg8::StaticOrder S; S.init(M, D, G, bid); pg8::EpiResid E{out, out, HB, ssq3, 1.0f};
        pg8::gemm_phase<pg8::EpiResid, pg8::StaticOrder, true, true>(lds, g, S, E); }
    SEAM(6);
    if (IN(7)) { pg8::Gemm g{HB, Wup2, M, NUP, D, D, D}; pg8::StaticOrder S; S.init(M, NUP, G, bid); pg8::EpiSwiglu E{R1, DFF, ssq3};
        pg8::gemm_phase<pg8::EpiSwiglu, pg8::StaticOrder, true, true>(lds, g, S, E); }
    SEAM(7);
    if (IN(8)) { pg8::Gemm g{R1, Wdn2, M, D, DFF, DFF, DFF}; pg8::StaticOrder S; S.init(M, D, G, bid); pg8::EpiResid E{out, out, nullptr, ssq4, 0.5f};
        pg8::gemm_phase<pg8::EpiResid, pg8::StaticOrder, true, true>(lds, g, S, E); }
    SEAM(8);
    if (IN(9)) { const float* gf = args.in[15]; const int gw = bid * NWAVES + wave, NGW = G * NWAVES;
        f32x4 gv[4];
#pragma unroll
        for (int j = 0; j < 4; ++j) gv[j] = ((const f32x4*)gf)[lane + 64 * j];
        for (int m = gw; m < M; m += NGW) { f32x4* xr = (f32x4*)(out + (size_t)m * D) + lane; const float rs = pg8::rstd_of(ssq4[m]);
#pragma unroll
            for (int j = 0; j < 4; ++j) { const f32x4 v = xr[64 * j]; xr[64 * j] = v * rs * gv[j]; } } }
#undef IN
#undef SEAM
}

extern "C" void kernel_launch(void* const* d_in, const int* in_sizes, int n_in, void* d_out, int out_size, void* d_ws, size_t ws_size, hipStream_t stream) {
    static int grid = 0;
    if (grid == 0) {
        if (n_in != 16 || in_sizes[0] != M * D || out_size != M * D || ws_size < WS_END) { fprintf(stderr, "kernel_launch: unexpected shapes (n_in %d, in0 %d, out %d, ws %zu < %zu)\n", n_in, n_in > 0 ? in_sizes[0] : -1, out_size, ws_size, (size_t)WS_END); grid = -1; return; }
        int dev = 0, cus = 0, per_cu = 0;
        if (hipGetDevice(&dev) != hipSuccess || hipDeviceGetAttribute(&cus, hipDeviceAttributeMultiprocessorCount, dev) != hipSuccess) { grid = -1; return; }
        if (hipFuncSetAttribute((const void*)mk_fwd, hipFuncAttributeMaxDynamicSharedMemorySize, LDS_BYTES) != hipSuccess) { fprintf(stderr, "kernel_launch: hipFuncSetAttribute failed\n"); grid = -1; return; }
        if (hipOccupancyMaxActiveBlocksPerMultiprocessor(&per_cu, (const void*)mk_fwd, NTHR, LDS_BYTES) != hipSuccess || per_cu < 1) { fprintf(stderr, "kernel_launch: occupancy query gave %d\n", per_cu); (void)hipGetLastError(); per_cu = 1; }
        grid = cus * per_cu;
    }
    if (grid < 0) return;
    Args a{};
    for (int i = 0; i < 16; ++i) a.in[i] = (const float*)d_in[i];
    a.out = (float*)d_out; a.ws = (unsigned char*)d_ws;
    if (MK_N_LAUNCHES == 1) {
        a.ph_lo = 0; a.ph_hi = NPHASE;
        void* kargs[] = {&a};
        hipError_t e = hipLaunchCooperativeKernel((const void*)mk_fwd, dim3(grid), dim3(NTHR), kargs, LDS_BYTES, stream);
        if (e != hipSuccess) fprintf(stderr, "cooperative launch failed: %s (grid %d)\n", hipGetErrorString(e), grid);
    } else {
        for (int p = 0; p < NPHASE; ++p) { a.ph_lo = p; a.ph_hi = p + 1; hipLaunchKernelGGL(mk_fwd, dim3(grid), dim3(NTHR), LDS_BYTES, stream, a); }
    }
}
```

```cpp
#include <hip/hip_runtime.h>
#include <hip/hip_cooperative_groups.h>
#include <cstdio>
#include <cstdint>
namespace cg = cooperative_groups;
namespace pg8 {
#define PG8_LAS __attribute__((address_space(3)))
typedef unsigned short bf16_t;
typedef short bf16x8 __attribute__((ext_vector_type(8)));
typedef float f32x4 __attribute__((ext_vector_type(4)));
typedef unsigned u32x4 __attribute__((ext_vector_type(4)));
constexpr int BM = 256, BK = 64, HALF = 128, HTB = HALF * BK * 2  , STAGE_BYTES = 8 * HTB, NXCD = 8, WGM = 8;

__host__ __device__ __forceinline__ int lds_byte(int r, int c) { const int st = (r >> 4) * 2 + (c >> 5), rr = r & 15, cc = c & 31, ob = rr * 64 + cc * 2; return st * 1024 + (ob ^ (((ob >> 9) & 1) << 5)); }
__host__ __device__ __forceinline__ void stage_rc(int b, int& R, int& C) { const int st = b / 1024, sb = b % 1024, swz = sb ^ (((sb >> 9) & 1) << 5); R = (st >> 1) * 16 + swz / 64; C = (st & 1) * 32 + (swz % 64) / 2; }
__host__ __device__ __forceinline__ int perm32(int rho) { const int n = rho >> 4, i = rho & 15; return 8 * (i >> 2) + 4 * n + (i & 3); }

struct Unit { int pm, pn; };
struct Gemm { const bf16_t* A; const bf16_t* Bt; int M, N, K, lda, ldb; };

struct StaticOrder {
    int nM, nN, nwg, G, c;
    __host__ __device__ void init(int M, int N, int G_, int c_) { nM = M / BM; nN = N / BM; nwg = nM * nN; G = G_; c = c_; }
    __host__ __device__ bool next(int i, Unit& u) const {
        const long L = (long)i * G + c; if (L >= nwg) return false;
        int wgid = (int)L; { const int q = nwg / NXCD, r = nwg % NXCD, xcd = wgid % NXCD, off = wgid / NXCD; wgid = (xcd < r ? xcd * (q + 1) : r * (q + 1) + (xcd - r) * q) + off; }
        const int nig = WGM * nN, gid = wgid / nig, fm = gid * WGM, gsz = (nM - fm) < WGM ? (nM - fm) : WGM;
        u.pm = fm + ((wgid % nig) % gsz); u.pn = (wgid % nig) / gsz; return true;
    }
    __device__ __forceinline__ void a_ready(const Unit&) const {}
    __device__ __forceinline__ void done(const Unit&) const {}
};

__device__ __forceinline__ unsigned cvt_pk_bf16(float lo, float hi) { unsigned r; asm volatile("v_cvt_pk_bf16_f32 %0, %1, %2" : "=v"(r) : "v"(lo), "v"(hi)); return r; }
typedef unsigned u32x2 __attribute__((ext_vector_type(2)));
constexpr float LOG2E = 1.4426950408889634f;
__device__ __forceinline__ float rstd_of(float ssq) { return __builtin_amdgcn_rsqf(ssq * (1.0f / 1024.0f) + 1e-6f); }
__device__ __forceinline__ float sigmoid_f(float v) { return __builtin_amdgcn_rcpf(1.0f + __builtin_amdgcn_exp2f(-v * LOG2E)); }
__device__ __forceinline__ float bf_lo(unsigned w) { return __uint_as_float(w << 16); }
__device__ __forceinline__ float bf_hi(unsigned w) { return __uint_as_float(w & 0xffff0000u); }

struct EpiSwiglu {
    static constexpr bool PERM = true, AFTER_DRAIN = false;
    bf16_t* O; int ldc; const float* ssq;
    __device__ __forceinline__ void operator()(const f32x4 (&acc)[2][2][4][2], const Unit& u, int wr, int wc, int fr, int fq) const {
        const int row0 = u.pm * BM + wr * 64 + fr, col0 = u.pn * HALF + wc * 32 + 8 * fq;
#pragma unroll
        for (int ai = 0; ai < 2; ++ai)
#pragma unroll
            for (int m = 0; m < 4; ++m) { const int row = row0 + ai * HALF + m * 16; const float rs = rstd_of(ssq[row]);
                float o[8];
#pragma unroll
                for (int n = 0; n < 2; ++n)
#pragma unroll
                    for (int e = 0; e < 4; ++e) { const float a = acc[ai][0][m][n][e] * rs, b = acc[ai][1][m][n][e] * rs; o[4 * n + e] = a * sigmoid_f(a) * b; }
                u32x4 w; w.x = cvt_pk_bf16(o[0], o[1]); w.y = cvt_pk_bf16(o[2], o[3]); w.z = cvt_pk_bf16(o[4], o[5]); w.w = cvt_pk_bf16(o[6], o[7]);
                *(u32x4*)(O + (size_t)row * ldc + col0) = w; }
    }
};
struct EpiResid {
    static constexpr bool PERM = false, AFTER_DRAIN = false;
    const float* base; float* out; bf16_t* hb; float* ssq; float alpha;
    __device__ __forceinline__ void operator()(const f32x4 (&acc)[2][2][4][2], const Unit& u, int wr, int wc, int fr, int fq) const {
        const int row0 = u.pm * BM + wr * 64 + fr, col0 = u.pn * BM + wc * 32 + 4 * fq;
#pragma unroll
        for (int ai = 0; ai < 2; ++ai)
#pragma unroll
            for (int m = 0; m < 4; ++m) { const int row = row0 + ai * HALF + m * 16; const size_t off = (size_t)row * 1024 + col0; float s = 0.f;
#pragma unroll
                for (int bj = 0; bj < 2; ++bj)
#pragma unroll
                    for (int n = 0; n < 2; ++n) { const size_t o2 = off + bj * HALF + n * 16; const f32x4 bs = *(const f32x4*)(base + o2); const f32x4 o = bs + acc[ai][bj][m][n] * alpha;
                        *(f32x4*)(out + o2) = o; s += (o[0] * o[0] + o[1] * o[1]) + (o[2] * o[2] + o[3] * o[3]);
                        if (hb) { u32x2 w; w.x = cvt_pk_bf16(o[0], o[1]); w.y = cvt_pk_bf16(o[2], o[3]); *(u32x2*)(hb + o2) = w; } }
                s += __shfl_xor(s, 16); s += __shfl_xor(s, 32);
                if (ssq && fq == 0) atomicAdd(ssq + row, s); }
    }
};
struct EpiIn {
    static constexpr bool PERM = true, AFTER_DRAIN = false;
    bf16_t* O; const float* ssq; float qscale;
    __device__ __forceinline__ void operator()(const f32x4 (&acc)[2][2][4][2], const Unit& u, int wr, int wc, int fr, int fq) const {
        const int row0 = u.pm * BM + wr * 64 + fr, col0 = u.pn * BM + wc * 32 + 8 * fq;
        const bool sig = u.pn >= 7; const float sc = u.pn < 4 ? qscale : 1.f;
#pragma unroll
        for (int ai = 0; ai < 2; ++ai)
#pragma unroll
            for (int m = 0; m < 4; ++m) { const int row = row0 + ai * HALF + m * 16; const float rs = rstd_of(ssq[row]) * sc;
#pragma unroll
                for (int bj = 0; bj < 2; ++bj) { f32x4 v0 = acc[ai][bj][m][0] * rs, v1 = acc[ai][bj][m][1] * rs;
                    if (sig) {
#pragma unroll
                        for (int e = 0; e < 4; ++e) { v0[e] = sigmoid_f(v0[e]); v1[e] = sigmoid_f(v1[e]); } }
                    u32x4 w; w.x = cvt_pk_bf16(v0[0], v0[1]); w.y = cvt_pk_bf16(v0[2], v0[3]); w.z = cvt_pk_bf16(v1[0], v1[1]); w.w = cvt_pk_bf16(v1[2], v1[3]);
                    *(u32x4*)(O + (size_t)row * 3840 + col0 + bj * HALF) = w; } }
    }
};
template <bool ACCUM> struct EpiGate {
    static constexpr bool PERM = true, AFTER_DRAIN = false;
    const bf16_t* Gt; bf16_t* MG;
    __device__ __forceinline__ void operator()(const f32x4 (&acc)[2][2][4][2], const Unit& u, int wr, int wc, int fr, int fq) const {
        const int row0 = u.pm * BM + wr * 64 + fr, col0 = u.pn * BM + wc * 32 + 8 * fq;
#pragma unroll
        for (int ai = 0; ai < 2; ++ai)
#pragma unroll
            for (int m = 0; m < 4; ++m) { const int row = row0 + ai * HALF + m * 16;
#pragma unroll
                for (int bj = 0; bj < 2; ++bj) { const int col = col0 + bj * HALF; const u32x4 gw = *(const u32x4*)(Gt + (size_t)row * 3840 + col);
                    const f32x4 a0 = acc[ai][bj][m][0], a1 = acc[ai][bj][m][1];
                    float o[8] = { bf_lo(gw.x) * a0[0], bf_hi(gw.x) * a0[1], bf_lo(gw.y) * a0[2], bf_hi(gw.y) * a0[3], bf_lo(gw.z) * a1[0], bf_hi(gw.z) * a1[1], bf_lo(gw.w) * a1[2], bf_hi(gw.w) * a1[3] };
                    bf16_t* mp = MG + (size_t)row * 1024 + col;
                    if (ACCUM) { const u32x4 ow = *(const u32x4*)mp; o[0] += bf_lo(ow.x); o[1] += bf_hi(ow.x); o[2] += bf_lo(ow.y); o[3] += bf_hi(ow.y); o[4] += bf_lo(ow.z); o[5] += bf_hi(ow.z); o[6] += bf_lo(ow.w); o[7] += bf_hi(ow.w); }
                    u32x4 w; w.x = cvt_pk_bf16(o[0], o[1]); w.y = cvt_pk_bf16(o[2], o[3]); w.z = cvt_pk_bf16(o[4], o[5]); w.w = cvt_pk_bf16(o[6], o[7]);
                    *(u32x4*)mp = w; } }
    }
};
template <class Epi, class Sched, bool ALIGN_EPI = false, bool SP2 = false>
__device__ __forceinline__ void gemm_phase(PG8_LAS unsigned char* lds, const Gemm g, const Sched& S, const Epi& E) {
    const int tid = threadIdx.x, wid = __builtin_amdgcn_readfirstlane(tid >> 6), lane = tid & 63, wr = wid >> 2, wc = wid & 3, fr = lane & 15, fq = lane >> 4;
    const int K = g.K, nt = K / BK;
    unsigned voffA[2], voffB[2];
#pragma unroll
    for (int i = 0; i < 2; ++i) { int R, C; stage_rc(tid * 16 + i * 8192, R, C); const int Rb = Epi::PERM ? ((R & ~31) + perm32(R & 31)) : R;
        voffA[i] = (unsigned)(R * g.lda + C) * 2u; voffB[i] = (unsigned)(Rb * g.ldb + C) * 2u; }
    const size_t kstep = (size_t)(BK * 2);
    const size_t hstepA = (size_t)HALF * g.lda * 2, hstepB = (size_t)HALF * g.ldb * 2;
    const size_t tstepA = 2 * hstepA, tstepB = 2 * hstepB;
    const unsigned ldsw = (unsigned)wid * 1024u;
    const int aoff = lds_byte(wr * 64 + fr, fq * 8), boff = lds_byte(wc * 32 + fr, fq * 8);
#define PG8_SA(b, h) (((b) * 2 + (h)) * HTB)
#define PG8_SB(b, h) ((4 + (b) * 2 + (h)) * HTB)
#define PG8_STAGE(bufoff, gbase, voff) do { _Pragma("unroll") for (int _i = 0; _i < 2; ++_i) \
        __builtin_amdgcn_global_load_lds((const unsigned*)((const char*)(gbase) + (voff)[_i]), (PG8_LAS unsigned*)(lds + (bufoff) + ldsw + _i * 8192), 16, 0, 0); } while (0)
#define PG8_LDA(dst, b, h) do { _Pragma("unroll") for (int m = 0; m < 4; ++m) _Pragma("unroll") for (int k = 0; k < 2; ++k) dst[m][k] = *(const PG8_LAS bf16x8*)(lds + PG8_SA(b, h) + aoff + m * 2048 + k * 1024); } while (0)
#define PG8_LDB(dst, b, h) do { _Pragma("unroll") for (int n = 0; n < 2; ++n) _Pragma("unroll") for (int k = 0; k < 2; ++k) dst[n][k] = *(const PG8_LAS bf16x8*)(lds + PG8_SB(b, h) + boff + n * 2048 + k * 1024); } while (0)
#define PG8_MMA(ai, bj, At, Bt) do { __builtin_amdgcn_s_setprio(1); _Pragma("unroll") for (int m = 0; m < 4; ++m) _Pragma("unroll") for (int n = 0; n < 2; ++n) _Pragma("unroll") for (int k = 0; k < 2; ++k) \
        acc[ai][bj][m][n] = __builtin_amdgcn_mfma_f32_16x16x32_bf16(Bt[n][k], At[m][k], acc[ai][bj][m][n], 0, 0, 0); __builtin_amdgcn_s_setprio(0); } while (0)
#define PG8_WAIT_V(n) asm volatile("s_waitcnt vmcnt(" #n ")" ::: "memory")
#define PG8_WAIT_L(n) asm volatile("s_waitcnt lgkmcnt(" #n ")" ::: "memory")
#define PG8_BAR __builtin_amdgcn_s_barrier()
#define PG8_SCHED __builtin_amdgcn_sched_barrier(0)
    Unit cur, nxt; int ui = 0;
    if (!S.next(0, cur)) return;
    f32x4 acc[2][2][4][2];
#pragma unroll
    for (int a = 0; a < 2; ++a)
#pragma unroll
        for (int b = 0; b < 2; ++b)
#pragma unroll
            for (int m = 0; m < 4; ++m)
#pragma unroll
                for (int n = 0; n < 2; ++n) acc[a][b][m][n] = (f32x4){0.f, 0.f, 0.f, 0.f};
    bf16x8 At[4][2], B0[2][2], B1[2][2];
    const char* cA = (const char*)g.A + (size_t)cur.pm * tstepA; const char* cB = (const char*)g.Bt + (size_t)cur.pn * tstepB;
    S.a_ready(cur);
    if constexpr (SP2) {
        PG8_STAGE(PG8_SB(0, 0), cB, voffB); PG8_STAGE(PG8_SB(0, 1), cB + hstepB, voffB); PG8_STAGE(PG8_SA(0, 0), cA, voffA); PG8_STAGE(PG8_SA(0, 1), cA + hstepA, voffA);
        if (wr == 1) PG8_BAR;
        PG8_WAIT_V(2); PG8_BAR;
        PG8_STAGE(PG8_SB(1, 0), cB + kstep, voffB); PG8_STAGE(PG8_SA(1, 0), cA + kstep, voffA); PG8_STAGE(PG8_SB(1, 1), cB + hstepB + kstep, voffB);
        PG8_WAIT_V(6); PG8_BAR;
    } else {
        PG8_STAGE(PG8_SB(0, 0), cB, voffB); PG8_STAGE(PG8_SA(0, 0), cA, voffA); PG8_STAGE(PG8_SB(0, 1), cB + hstepB, voffB); PG8_STAGE(PG8_SA(0, 1), cA + hstepA, voffA);
        if (wr == 1) PG8_BAR;
        PG8_WAIT_V(4); PG8_BAR;
        PG8_STAGE(PG8_SB(1, 0), cB + kstep, voffB); PG8_STAGE(PG8_SA(1, 0), cA + kstep, voffA); PG8_STAGE(PG8_SB(1, 1), cB + hstepB + kstep, voffB);
        PG8_WAIT_V(6); PG8_BAR;
    }
    for (;;) {
        const bool has_next = S.next(ui + 1, nxt);
        const char* nA = has_next ? (const char*)g.A + (size_t)nxt.pm * tstepA : cA; const char* nB = has_next ? (const char*)g.Bt + (size_t)nxt.pn * tstepB : cB;
        for (int t = 0; t < nt; t += 2) {
            const bool last = (t == nt - 2);
            const char* a1 = cA + (size_t)(t + 1) * kstep;
            const char* a2 = last ? nA : cA + (size_t)(t + 2) * kstep; const char* b2 = last ? nB : cB + (size_t)(t + 2) * kstep;
            const char* a3 = a2 + kstep; const char* b3 = b2 + kstep;
            if (last && has_next) S.a_ready(nxt);
            if constexpr (SP2) {
            PG8_LDB(B0, 0, 0); PG8_LDB(B1, 0, 1); PG8_SCHED; PG8_LDA(At, 0, 0); PG8_STAGE(PG8_SA(1, 1), a1 + hstepA, voffA);
            PG8_WAIT_V(8); PG8_WAIT_L(0); PG8_BAR; PG8_MMA(0, 0, At, B0); PG8_MMA(0, 1, At, B1); PG8_BAR; PG8_SCHED;
            PG8_LDA(At, 0, 1); PG8_STAGE(PG8_SB(0, 0), b2, voffB); PG8_STAGE(PG8_SB(0, 1), b2 + hstepB, voffB); PG8_STAGE(PG8_SA(0, 0), a2, voffA);
            PG8_WAIT_V(8); PG8_WAIT_L(0); PG8_BAR; PG8_MMA(1, 0, At, B0); PG8_MMA(1, 1, At, B1); PG8_BAR; PG8_SCHED;
            PG8_LDB(B0, 1, 0); PG8_LDB(B1, 1, 1); PG8_SCHED; PG8_LDA(At, 1, 0); PG8_STAGE(PG8_SA(0, 1), a2 + hstepA, voffA);
            PG8_WAIT_V(8); PG8_WAIT_L(0); PG8_BAR; PG8_MMA(0, 0, At, B0); PG8_MMA(0, 1, At, B1); PG8_BAR; PG8_SCHED;
            PG8_LDA(At, 1, 1); PG8_STAGE(PG8_SB(1, 0), b3, voffB); PG8_STAGE(PG8_SB(1, 1), b3 + hstepB, voffB); PG8_STAGE(PG8_SA(1, 0), a3, voffA);
            PG8_WAIT_V(8); PG8_WAIT_L(0); PG8_BAR; PG8_MMA(1, 0, At, B0); PG8_MMA(1, 1, At, B1); PG8_BAR; PG8_SCHED;
            } else {
            PG8_LDB(B0, 0, 0); PG8_SCHED; PG8_LDA(At, 0, 0); PG8_STAGE(PG8_SA(1, 1), a1 + hstepA, voffA);
            PG8_WAIT_L(8); PG8_BAR; PG8_WAIT_L(0); PG8_MMA(0, 0, At, B0); PG8_BAR; PG8_SCHED;
            PG8_LDB(B1, 0, 1); PG8_STAGE(PG8_SB(0, 0), b2, voffB);
            PG8_BAR; PG8_WAIT_L(0); PG8_MMA(0, 1, At, B1); PG8_BAR;
            PG8_LDA(At, 0, 1); PG8_STAGE(PG8_SA(0, 0), a2, voffA);
            PG8_BAR; PG8_WAIT_L(0); PG8_MMA(1, 0, At, B0); PG8_BAR; PG8_SCHED;
            PG8_STAGE(PG8_SB(0, 1), b2 + hstepB, voffB);
            PG8_WAIT_V(6); PG8_BAR; PG8_MMA(1, 1, At, B1); PG8_BAR;
            PG8_LDB(B0, 1, 0); PG8_SCHED; PG8_LDA(At, 1, 0); PG8_STAGE(PG8_SA(0, 1), a2 + hstepA, voffA);
            PG8_WAIT_L(8); PG8_BAR; PG8_WAIT_L(0); PG8_MMA(0, 0, At, B0); PG8_BAR; PG8_SCHED;
            PG8_LDB(B1, 1, 1); PG8_STAGE(PG8_SB(1, 0), b3, voffB);
            PG8_BAR; PG8_WAIT_L(0); PG8_MMA(0, 1, At, B1); PG8_BAR;
            PG8_LDA(At, 1, 1); PG8_STAGE(PG8_SA(1, 0), a3, voffA);
            PG8_BAR; PG8_WAIT_L(0); PG8_MMA(1, 0, At, B0); PG8_BAR; PG8_SCHED;
            PG8_STAGE(PG8_SB(1, 1), b3 + hstepB, voffB);
            PG8_WAIT_V(6); PG8_BAR; PG8_MMA(1, 1, At, B1); PG8_BAR;
            }
        }
        if constexpr (ALIGN_EPI) { if (wr == 0) PG8_BAR; }
        if constexpr (!Epi::AFTER_DRAIN) { E(acc, cur, wr, wc, fr, fq); S.done(cur); }
        if (!has_next) break;
#pragma unroll
        for (int a = 0; a < 2; ++a)
#pragma unroll
            for (int b = 0; b < 2; ++b)
#pragma unroll
                for (int m = 0; m < 4; ++m)
#pragma unroll
                    for (int n = 0; n < 2; ++n) acc[a][b][m][n] = (f32x4){0.f, 0.f, 0.f, 0.f};
        cur = nxt; cA = nA; cB = nB; ++ui;
        if constexpr (ALIGN_EPI) { if (wr == 1) PG8_BAR; }
    }
    PG8_WAIT_V(0);
    if constexpr (!ALIGN_EPI) { if (wr == 0) PG8_BAR; }
    PG8_BAR;
    if constexpr (Epi::AFTER_DRAIN) { E.fused(acc, cur, wr, wc, fr, fq, lds, wid, lane); S.done(cur); }
#undef PG8_SA
#undef PG8_SB
#undef PG8_STAGE
#undef PG8_LDA
#undef PG8_LDB
#undef PG8_MMA
#undef PG8_WAIT_V
#undef PG8_WAIT_L
#undef PG8_BAR
#undef PG8_SCHED
}
}
#define LAS __attribute__((address_space(3)))
typedef unsigned short bf16;
typedef unsigned u32x4 __attribute__((ext_vector_type(4)));
typedef unsigned u32x2 __attribute__((ext_vector_type(2)));
typedef float f32x4 __attribute__((ext_vector_type(4)));
typedef float f32x16 __attribute__((ext_vector_type(16)));
typedef short bf16x8 __attribute__((ext_vector_type(8)));
constexpr int NWAVES = 8, NTHR = 512;
constexpr int BATCH = 4, SEQ = 8192, D = 1024, M = BATCH * SEQ, DFF = 2816, NUP = 2 * DFF, NIN = 3840, PW = 512;
constexpr int COL_K = 1024, COL_V = 1152, COL_Z = 1280, COL_GA = 1792, COL_GP = 2816;
constexpr float LOG2E = 1.4426950408889634f;
constexpr size_t MiB = 1u << 20;
constexpr size_t WS_SSQ = 0;
constexpr size_t WS_BAR = 512 * 1024, BAR_BYTES = 16384;
constexpr size_t WS_WUP1 = 1 * MiB, WS_WDN1 = 12 * MiB, WS_WIN = 18 * MiB, WS_WATT = 26 * MiB, WS_WEFF = 28 * MiB, WS_WOUT = 29 * MiB, WS_WUP2 = 31 * MiB, WS_WDN2 = 42 * MiB;
constexpr size_t WS_HB = 48 * MiB;
constexpr size_t WS_R1 = 112 * MiB;
constexpr size_t WS_PL = 352 * MiB;
constexpr size_t WS_MG = 384 * MiB;
constexpr size_t WS_END = 448 * MiB;
constexpr int LDS_BYTES = 147456;
constexpr int NPHASE = 10;
#ifndef MK_N_LAUNCHES
#define MK_N_LAUNCHES 1
#endif

__device__ __forceinline__ unsigned f2bf(float f) { unsigned u = __builtin_bit_cast(unsigned, f); return (u + 0x7fffu + ((u >> 16) & 1u)) >> 16; }
__device__ __forceinline__ unsigned pk2(float lo, float hi) { return f2bf(lo) | (f2bf(hi) << 16); }
__device__ __forceinline__ float bf2f(bf16 v) { return __uint_as_float((unsigned)v << 16); }
__device__ __forceinline__ float wave_sum(float v) {
#pragma unroll
    for (int o = 1; o < 64; o <<= 1) v += __shfl_xor(v, o);
    return v;
}
__device__ __forceinline__ void transpose_item(const float* W, int K, int N, bf16* WT, const float* gain, bool swiglu, LAS float* scr, int item, int lane) {
    const int nblk = N / 32, kb = item / nblk, nb = item % nblk, k0 = 64 * kb, n0 = 32 * nb;
    int dr = n0;
    if (swiglu) { if (n0 < DFF) dr = 256 * (n0 / 128) + (n0 % 128); else { const int j = n0 - DFF; dr = 256 * (j / 128) + 128 + (j % 128); } }
    float v[32];
#pragma unroll
    for (int i = 0; i < 32; ++i) v[i] = W[(size_t)(k0 + 2 * i + (lane >> 5)) * N + n0 + (lane & 31)];
    if (gain) {
#pragma unroll
        for (int i = 0; i < 32; ++i) v[i] *= gain[k0 + 2 * i + (lane >> 5)]; }
#pragma unroll
    for (int i = 0; i < 32; ++i) scr[(2 * i + (lane >> 5)) * 33 + (lane & 31)] = v[i];
    asm volatile("s_waitcnt lgkmcnt(0)" ::: "memory");
    const int c = lane & 7;
#pragma unroll
    for (int j = 0; j < 4; ++j) { const int n = (lane >> 3) + 8 * j; const LAS float* s = scr + (8 * c) * 33 + n;
        u32x4 o; o.x = pk2(s[0 * 33], s[1 * 33]); o.y = pk2(s[2 * 33], s[3 * 33]); o.z = pk2(s[4 * 33], s[5 * 33]); o.w = pk2(s[6 * 33], s[7 * 33]);
        *(u32x4*)(WT + (size_t)(dr + n) * K + k0 + 8 * c) = o; }
    asm volatile("s_waitcnt lgkmcnt(0)" ::: "memory");
}

struct Args { const float* in[16]; float* out; unsigned char* ws; int ph_lo, ph_hi; };

#define XB_TMO      128
#define XB_XCNT(j)  (256  + 64 * (j))
#define XB_XSUB(j)  (1280 + 64 * (j))
#define XB_XGEN(j)  (2304 + 64 * (j))
#define XB_TOP      3328
#define XB_TOPGEN   3392
#define XCD_BAR_WORDS 3456
#define XB_SPIN_CAP (1u << 18)

__device__ __forceinline__ unsigned xb_ld(unsigned* p)              { return __hip_atomic_load(p, __ATOMIC_RELAXED, __HIP_MEMORY_SCOPE_AGENT); }
__device__ __forceinline__ unsigned xb_add(unsigned* p, unsigned v) { return __hip_atomic_fetch_add(p, v, __ATOMIC_RELAXED, __HIP_MEMORY_SCOPE_AGENT); }
__device__ __forceinline__ unsigned xb_xcc_id() { return (unsigned)__builtin_amdgcn_s_getreg((3 << 11) | 20) & 0xFu; }
#define XB_SPIN(cond, bar) do { unsigned _sp = 0; while (cond) { __builtin_amdgcn_s_sleep(1); \
    if ((++_sp & 255u) == 0u) { if (xb_ld(&(bar)[XB_TMO])) break; if (_sp > XB_SPIN_CAP) { atomicAdd(&(bar)[XB_TMO], 1u); break; } } } } while (0)

struct XcdBarrier {
    unsigned* bar; unsigned x;
    volatile LAS unsigned* st;
};

__device__ __forceinline__ XcdBarrier xcd_barrier_post(unsigned* bar, volatile LAS unsigned* st) {
    XcdBarrier b; b.bar = bar; b.x = xb_xcc_id(); b.st = st;
    if (threadIdx.x == 0) (void)xb_add(&bar[XB_XCNT(b.x)], 1u);
    return b;
}
__device__ __forceinline__ void xcd_barrier_complete(unsigned* bar, unsigned x, unsigned& nloc, unsigned& nx) {
    const unsigned G = gridDim.x * gridDim.y * gridDim.z;
    unsigned sum, cnt, mine, sp = 0u;
    for (;;) {
        sum = 0u; cnt = 0u; mine = 0u;
#pragma unroll
        for (unsigned j = 0; j < 16; ++j) { const unsigned c = xb_ld(&bar[XB_XCNT(j)]); sum += c; cnt += (c > 0u) ? 1u : 0u; mine = (j == x) ? c : mine; }
        if (sum == G) break;
        __builtin_amdgcn_s_sleep(1);
        if ((++sp & 255u) == 0u) { if (xb_ld(&bar[XB_TMO])) break; if (sp > XB_SPIN_CAP) { atomicAdd(&bar[XB_TMO], 1u); break; } }
    }
    nloc = mine > 0u ? mine : 1u; nx = cnt > 0u ? cnt : 1u;
}

__device__ __forceinline__ void xcd_barrier(const XcdBarrier& b) {
    asm volatile("s_waitcnt vmcnt(0)" ::: "memory");
    __syncthreads();
    if (threadIdx.x == 0) {
        unsigned* bar = b.bar;
        __builtin_amdgcn_s_waitcnt(0);
        unsigned nloc = b.st[0], nx = b.st[1];
        if (nloc == 0u) { xcd_barrier_complete(bar, b.x, nloc, nx); b.st[0] = nloc; b.st[1] = nx; }
        const unsigned old = xb_add(&bar[XB_XSUB(b.x)], 1u);
        const unsigned gen = old / nloc;
        if (old + 1u == (gen + 1u) * nloc) {
            __builtin_amdgcn_fence(__ATOMIC_RELEASE, "agent");
            asm volatile("s_waitcnt vmcnt(0)" ::: "memory");
            const unsigned og = xb_add(&bar[XB_TOP], 1u);
            const unsigned tg = og / nx;
            if (og + 1u == (tg + 1u) * nx) xb_add(&bar[XB_TOPGEN], 1u);
            else XB_SPIN(xb_ld(&bar[XB_TOPGEN]) == tg, bar);
            __builtin_amdgcn_fence(__ATOMIC_ACQUIRE, "agent");
            xb_add(&bar[XB_XGEN(b.x)], 1u);
            asm volatile("s_waitcnt vmcnt(0)" ::: "memory");
        } else {
            XB_SPIN(xb_ld(&bar[XB_XGEN(b.x)]) == gen, bar);
            __builtin_amdgcn_fence(__ATOMIC_ACQUIRE, "agent");
            asm volatile("s_waitcnt vmcnt(0)" ::: "memory");
        }
    }
    __syncthreads();
}

constexpr int KROWB = 144, VROWB = 520, LDS_VT = 256 * KROWB;
template <int W> __device__ __forceinline__ void pool_item(const bf16* zp, bf16* pl, int t0) {
    float zr[W - 1 + 32];
#pragma unroll
    for (int j = 0; j < W - 1 + 32; ++j) { const int tt = j - (W - 1); zr[j] = (t0 + tt >= 0) ? bf2f(zp[(long)tt * NIN]) : 0.f; }
    float s = 0.f;
#pragma unroll
    for (int j = 0; j < W - 1; ++j) s += zr[j];
#pragma unroll
    for (int tt = 0; tt < 32; ++tt) { const float z = zr[W - 1 + tt]; s += z; const int t = t0 + tt;
        const float o = s * (t + 1 >= W ? 1.0f / (float)W : 1.0f / (float)(t + 1)) - z;
        pl[(size_t)tt * PW] = (bf16)f2bf(o);
        s -= zr[tt]; }
}
__device__ __forceinline__ void attn_pool_phase(LAS unsigned char* lds, bf16* QKV, bf16* PL, const float* sinks, int G, int bid) {
    const int tid = threadIdx.x, lane = tid & 63, wid = __builtin_amdgcn_readfirstlane(tid >> 6), q = lane & 31, hi = lane >> 5;
    for (int unit = bid; unit < BATCH * 64 * 2; unit += G) {
        const int hk = unit & 1, n = (unit >> 1) & 63, b = unit >> 7;
        const size_t rowbase = (size_t)b * SEQ; const int kpos0 = (n - 1) * 128;
        const int h = hk * 8 + wid;
        bf16* qbase = QKV + (rowbase + n * 128 + q) * NIN + h * 64 + 8 * hi;
        bf16x8 qn[4];
#pragma unroll
        for (int d0 = 0; d0 < 4; ++d0) qn[d0] = *(const bf16x8*)(qbase + d0 * 16);
        u32x4 kv[4], vv[4];
#pragma unroll
        for (int i = 0; i < 4; ++i) { const int id = tid + NTHR * i, r = id >> 3, c = id & 7, pos = kpos0 + r;
            kv[i] = (u32x4){0u, 0u, 0u, 0u}; vv[i] = (u32x4){0u, 0u, 0u, 0u};
            if (pos >= 0) { const bf16* p = QKV + (rowbase + pos) * NIN + COL_K + hk * 64 + c * 8; kv[i] = *(const u32x4*)p; vv[i] = *(const u32x4*)(p + 128); } }
#pragma unroll
        for (int i = 0; i < 4; ++i) { const int id = tid + NTHR * i, r = id >> 3, c = id & 7;
            *(LAS u32x4*)(lds + r * KROWB + c * 16) = kv[i];
            LAS unsigned short* vt = (LAS unsigned short*)(lds + LDS_VT) + (c * 8) * (VROWB / 2) + r;
            vt[0 * (VROWB / 2)] = (unsigned short)(vv[i].x & 0xffffu); vt[1 * (VROWB / 2)] = (unsigned short)(vv[i].x >> 16);
            vt[2 * (VROWB / 2)] = (unsigned short)(vv[i].y & 0xffffu); vt[3 * (VROWB / 2)] = (unsigned short)(vv[i].y >> 16);
            vt[4 * (VROWB / 2)] = (unsigned short)(vv[i].z & 0xffffu); vt[5 * (VROWB / 2)] = (unsigned short)(vv[i].z >> 16);
            vt[6 * (VROWB / 2)] = (unsigned short)(vv[i].w & 0xffffu); vt[7 * (VROWB / 2)] = (unsigned short)(vv[i].w >> 16); }
        __syncthreads();
        const float slopeL = __builtin_bit_cast(float, __builtin_amdgcn_readfirstlane(__builtin_bit_cast(int, __builtin_amdgcn_exp2f(-0.5f * (float)(h + 1)) * LOG2E))), sink2 = sinks[h] * LOG2E;
        for (int i = 0; i < 4; ++i) {
            bf16* qp = qbase + (size_t)(32 * i) * NIN - 8 * hi;
            bf16x8 qf[4];
#pragma unroll
            for (int d0 = 0; d0 < 4; ++d0) qf[d0] = qn[d0];
            if (i < 3) {
#pragma unroll
                for (int d0 = 0; d0 < 4; ++d0) qn[d0] = *(const bf16x8*)(qbase + (size_t)(32 * (i + 1)) * NIN + d0 * 16); }
            f32x16 S[5];
#pragma unroll
            for (int j = 0; j < 5; ++j) { const LAS unsigned char* kp = lds + (32 * (i + j) + q) * KROWB + hi * 16;
                f32x16 a = {};
#pragma unroll
                for (int d0 = 0; d0 < 4; ++d0) a = __builtin_amdgcn_mfma_f32_32x32x16_bf16(*(const LAS bf16x8*)(kp + d0 * 32), qf[d0], a, 0, 0, 0);
                S[j] = a; }
            float mx = sink2;
            int qo = q - 4 * hi; asm volatile("" : "+v"(qo));
            const float lb = -slopeL * (float)(128 + qo);
#pragma unroll
            for (int j = 0; j < 5; ++j) { const bool tile_ok = !(n == 0 && i + j < 4); const float lbj = lb + slopeL * (32.0f * (float)j);
#pragma unroll
                for (int r = 0; r < 16; ++r) { const int crc = (r & 3) + 8 * (r >> 2);
                    float s = S[j][r] + (lbj + slopeL * (float)crc);
                    if (j == 0) s = (crc > qo) ? s : -INFINITY;
                    if (j == 4) s = (crc <= qo) ? s : -INFINITY;
                    if (!tile_ok) s = -INFINITY;
                    S[j][r] = s; mx = fmaxf(mx, s); } }
            mx = fmaxf(mx, __shfl_xor(mx, 32));
            float l = 0.f;
#pragma unroll
            for (int j = 0; j < 5; ++j)
#pragma unroll
                for (int r = 0; r < 16; ++r) { const float p = __builtin_amdgcn_exp2f(S[j][r] - mx); S[j][r] = p; l += p; }
            l += __shfl_xor(l, 32); l += __builtin_amdgcn_exp2f(sink2 - mx);
            f32x16 o0 = {}, o1 = {};
#pragma unroll
            for (int j = 0; j < 5; ++j)
#pragma unroll
                for (int c = 0; c < 2; ++c) {
                    u32x4 pw; pw.x = pg8::cvt_pk_bf16(S[j][8 * c + 0], S[j][8 * c + 1]); pw.y = pg8::cvt_pk_bf16(S[j][8 * c + 2], S[j][8 * c + 3]);
                    pw.z = pg8::cvt_pk_bf16(S[j][8 * c + 4], S[j][8 * c + 5]); pw.w = pg8::cvt_pk_bf16(S[j][8 * c + 6], S[j][8 * c + 7]);
                    const bf16x8 pb = __builtin_bit_cast(bf16x8, pw);
                    const LAS unsigned char* vp = lds + LDS_VT + q * VROWB + (32 * (i + j) + 16 * c + 4 * hi) * 2;
                    const u32x2 a0 = *(const LAS u32x2*)vp, a1 = *(const LAS u32x2*)(vp + 16), b0 = *(const LAS u32x2*)(vp + 32 * VROWB), b1 = *(const LAS u32x2*)(vp + 32 * VROWB + 16);
                    const bf16x8 va = __builtin_bit_cast(bf16x8, (u32x4){a0.x, a0.y, a1.x, a1.y}), vb = __builtin_bit_cast(bf16x8, (u32x4){b0.x, b0.y, b1.x, b1.y});
                    o0 = __builtin_amdgcn_mfma_f32_32x32x16_bf16(va, pb, o0, 0, 0, 0);
                    o1 = __builtin_amdgcn_mfma_f32_32x32x16_bf16(vb, pb, o1, 0, 0, 0); }
            const float inv = 1.0f / l;
#pragma unroll
            for (int rg = 0; rg < 4; ++rg) { const int d = 8 * rg + 4 * hi;
                u32x2 w0, w1; w0.x = pg8::cvt_pk_bf16(o0[4 * rg] * inv, o0[4 * rg + 1] * inv); w0.y = pg8::cvt_pk_bf16(o0[4 * rg + 2] * inv, o0[4 * rg + 3] * inv);
                w1.x = pg8::cvt_pk_bf16(o1[4 * rg] * inv, o1[4 * rg + 1] * inv); w1.y = pg8::cvt_pk_bf16(o1[4 * rg + 2] * inv, o1[4 * rg + 3] * inv);
                *(u32x2*)(qp + d) = w0; *(u32x2*)(qp + 32 + d) = w1; }
        }
        __syncthreads();
    }
    for (int item = bid; item < M / 32; item += G) {
        const int row0 = item * 32, t0 = row0 & (SEQ - 1), c = tid, g = __builtin_amdgcn_readfirstlane(c >> 7);
        const bf16* zp = QKV + (size_t)row0 * NIN + COL_Z + c; bf16* pl = PL + (size_t)row0 * PW + c;
        if (g == 0) pool_item<2>(zp, pl, t0); else if (g == 1) pool_item<4>(zp, pl, t0); else if (g == 2) pool_item<8>(zp, pl, t0); else pool_item<16>(zp, pl, t0);
    }
}

__global__ void __launch_bounds__(NTHR, 2) mk_fwd(Args args) {
    extern __shared__ __attribute__((aligned(16))) unsigned char lds_raw[];
    LAS unsigned char* lds = (LAS unsigned char*)lds_raw;
    cg::grid_group grid = cg::this_grid();
    const int tid = threadIdx.x, lane = tid & 63, wave = __builtin_amdgcn_readfirstlane(tid >> 6);
    const int G = gridDim.x, bid = blockIdx.x;
    const int lo = args.ph_lo, hi = args.ph_hi;
    unsigned char* ws = args.ws;
    const float* x = args.in[0]; float* out = args.out;
    float* ssq1 = (float*)(ws + WS_SSQ); float* ssq2 = ssq1 + M; float* ssq3 = ssq2 + M; float* ssq4 = ssq3 + M;
    bf16* Wup1 = (bf16*)(ws + WS_WUP1); bf16* Wdn1 = (bf16*)(ws + WS_WDN1); bf16* Win = (bf16*)(ws + WS_WIN); bf16* Watt = (bf16*)(ws + WS_WATT);
    bf16* Weff = (bf16*)(ws + WS_WEFF); bf16* Wout = (bf16*)(ws + WS_WOUT); bf16* Wup2 = (bf16*)(ws + WS_WUP2); bf16* Wdn2 = (bf16*)(ws + WS_WDN2);
    bf16* HB = (bf16*)(ws + WS_HB); bf16* R1 = (bf16*)(ws + WS_R1); bf16* PL = (bf16*)(ws + WS_PL); bf16* MG = (bf16*)(ws + WS_MG);
#ifdef MK_ONLY
#define IN(k) ((k) == MK_ONLY && lo <= (k) && (k) < hi)
#else
#define IN(k) (lo <= (k) && (k) < hi)
#endif
    volatile LAS unsigned* misc = (volatile LAS unsigned*)(lds + 131072);
    if (tid < 16) misc[tid] = 0u;
    __syncthreads();
    XcdBarrier bar = xcd_barrier_post((unsigned*)(ws + WS_BAR), misc + 8);
    if (hi > NPHASE + 100) grid.sync();
#define SEAM(k) do { if (IN(k) && IN((k) + 1)) xcd_barrier(bar); } while (0)

    if (IN(0)) {
        { const float* wmix = args.in[8]; const float* pscale = args.in[9]; const float* wpool = args.in[10];
          LAS float* wmL = (LAS float*)lds; LAS float* wpL = wmL + 128 * 129;
          for (int wi = bid; wi < 256; wi += G) { const int g = wi >> 6, n0 = (wi & 63) * 16;
              for (int e = tid; e < 128 * 128; e += NTHR) { const int k = e >> 7, c = e & 127; wmL[k * 129 + c] = wmix[g * 16384 + e] * pscale[g * 128 + c]; }
              for (int e = tid; e < 128 * 16; e += NTHR) { const int c = e >> 4, j = e & 15; wpL[e] = wpool[(size_t)(g * 128 + c) * D + n0 + j]; }
              __syncthreads();
              const int k = tid >> 2, j0 = (tid & 3) * 4; float s0 = 0.f, s1 = 0.f, s2 = 0.f, s3 = 0.f;
#pragma unroll 8
              for (int c = 0; c < 128; ++c) { const float a = wmL[k * 129 + c]; const f32x4 bq = *(const LAS f32x4*)(wpL + c * 16 + j0); s0 += a * bq.x; s1 += a * bq.y; s2 += a * bq.z; s3 += a * bq.w; }
              bf16* wo = Weff + (size_t)(n0 + j0) * PW + g * 128 + k;
              wo[0] = (bf16)f2bf(s0); wo[PW] = (bf16)f2bf(s1); wo[2 * PW] = (bf16)f2bf(s2); wo[3 * PW] = (bf16)f2bf(s3);
              __syncthreads(); } }
        LAS float* scr = (LAS float*)(lds + wave * 16384);
        const int gw = bid * NWAVES + wave, NGW = G * NWAVES;
        constexpr int I_UP = (D / 64) * (NUP / 32), I_DN = (DFF / 64) * (D / 32), I_IN = (D / 64) * (NIN / 32), I_SQ = (D / 64) * (D / 32);
        constexpr int NITEMS = 2 * I_UP + 2 * I_DN + I_IN + 2 * I_SQ;
        for (int it = gw; it < NITEMS; it += NGW) {
            int r = it;
            if (r < I_UP) { transpose_item(args.in[2], D, NUP, Wup1, args.in[1], true, scr, r, lane); continue; } r -= I_UP;
            if (r < I_UP) { transpose_item(args.in[13], D, NUP, Wup2, args.in[12], true, scr, r, lane); continue; } r -= I_UP;
            if (r < I_DN) { transpose_item(args.in[3], DFF, D, Wdn1, nullptr, false, scr, r, lane); continue; } r -= I_DN;
            if (r < I_DN) { transpose_item(args.in[14], DFF, D, Wdn2, nullptr, false, scr, r, lane); continue; } r -= I_DN;
            if (r < I_IN) { transpose_item(args.in[5], D, NIN, Win, args.in[4], false, scr, r, lane); continue; } r -= I_IN;
            if (r < I_SQ) { transpose_item(args.in[7], D, D, Watt, nullptr, false, scr, r, lane); continue; } r -= I_SQ;
            transpose_item(args.in[11], D, D, Wout, nullptr, false, scr, r, lane);
        }
        for (int m = gw; m < M; m += 2 * NGW) { const int m2 = m + NGW; const bool has2 = m2 < M;
            const f32x4* xa = (const f32x4*)(x + (size_t)m * D) + lane; const f32x4* xb = (const f32x4*)(x + (size_t)(has2 ? m2 : m) * D) + lane;
            f32x4 va[4], vb[4];
#pragma unroll
            for (int j = 0; j < 4; ++j) { va[j] = xa[64 * j]; vb[j] = xb[64 * j]; }
            float sa = 0.f, sb = 0.f; unsigned long long* oa = (unsigned long long*)(HB + (size_t)m * D) + lane; unsigned long long* ob = (unsigned long long*)(HB + (size_t)m2 * D) + lane;
#pragma unroll
            for (int j = 0; j < 4; ++j) { sa += (va[j].x * va[j].x + va[j].y * va[j].y) + (va[j].z * va[j].z + va[j].w * va[j].w); sb += (vb[j].x * vb[j].x + vb[j].y * vb[j].y) + (vb[j].z * vb[j].z + vb[j].w * vb[j].w);
                oa[64 * j] = (unsigned long long)pk2(va[j].x, va[j].y) | ((unsigned long long)pk2(va[j].z, va[j].w) << 32);
                if (has2) ob[64 * j] = (unsigned long long)pk2(vb[j].x, vb[j].y) | ((unsigned long long)pk2(vb[j].z, vb[j].w) << 32); }
            sa = wave_sum(sa); sb = wave_sum(sb); if (lane == 0) { ssq1[m] = sa; if (has2) ssq1[m2] = sb; } }
        for (int idx = bid * NTHR + tid; idx < 3 * M; idx += G * NTHR) ssq2[idx] = 0.f;
    }
    SEAM(0);
    if (IN(1)) { pg8::Gemm g{HB, Wup1, M, NUP, D, D, D}; pg8::StaticOrder S; S.init(M, NUP, G, bid); pg8::EpiSwiglu E{R1, DFF, ssq1};
        pg8::gemm_phase<pg8::EpiSwiglu, pg8::StaticOrder, true, true>(lds, g, S, E); }
    SEAM(1);
    if (IN(2)) { pg8::Gemm g{R1, Wdn1, M, D, DFF, DFF, DFF}; pg8::StaticOrder S; S.init(M, D, G, bid); pg8::EpiResid E{x, out, HB, ssq2, 0.5f};
        pg8::gemm_phase<pg8::EpiResid, pg8::StaticOrder, true, true>(lds, g, S, E); }
    SEAM(2);
    if (IN(3)) { pg8::Gemm g{HB, Win, M, NIN, D, D, D}; pg8::StaticOrder S; S.init(M, NIN, G, bid); pg8::EpiIn E{R1, ssq2, 0.125f * LOG2E};
        pg8::gemm_phase<pg8::EpiIn, pg8::StaticOrder, true, true>(lds, g, S, E); }
    SEAM(3);
    if (IN(4)) attn_pool_phase(lds, R1, PL, args.in[6], G, bid);
    SEAM(4);
    if (IN(5)) {
        { pg8::Gemm g{R1, Watt, M, D, D, NIN, D}; pg8::StaticOrder S; S.init(M, D, G, bid); pg8::EpiGate<false> E{R1 + COL_GA, MG};
          pg8::gemm_phase<pg8::EpiGate<false>, pg8::StaticOrder, true, true>(lds, g, S, E); }
        { pg8::Gemm g{PL, Weff, M, D, PW, PW, PW}; pg8::StaticOrder S; S.init(M, D, G, bid); pg8::EpiGate<true> E{R1 + COL_GP, MG};
          pg8::gemm_phase<pg8::EpiGate<true>, pg8::StaticOrder, true, true>(lds, g, S, E); }
    }
    SEAM(5);
    if (IN(6)) { pg8::Gemm g{MG, Wout, M, D, D, D, D}; pg8::StaticOrder S; S.init(M, D, G, bid); pg8::EpiResid E{out, out, HB, ssq3, 1.0f};
        pg8::gemm_phase<pg8::EpiResid, pg8::StaticOrder, true, true>(lds, g, S, E); }
    SEAM(6);
    if (IN(7)) { pg8::Gemm g{HB, Wup2, M, NUP, D, D, D}; pg8::StaticOrder S; S.init(M, NUP, G, bid); pg8::EpiSwiglu E{R1, DFF, ssq3};
        pg8::gemm_phase<pg8::EpiSwiglu, pg8::StaticOrder, true, true>(lds, g, S, E); }
    SEAM(7);
    if (IN(8)) { pg8::Gemm g{R1, Wdn2, M, D, DFF, DFF, DFF}; pg8::StaticOrder S; S.init(M, D, G, bid); pg8::EpiResid E{out, out, nullptr, ssq4, 0.5f};
        pg8::gemm_phase<pg8::EpiResid, pg8::StaticOrder, true, true>(lds, g, S, E); }
    SEAM(8);
    if (IN(9)) { const float* gf = args.in[15]; const int gw = bid * NWAVES + wave, NGW = G * NWAVES;
        f32x4 gv[4];
#pragma unroll
        for (int j = 0; j < 4; ++j) gv[j] = ((const f32x4*)gf)[lane + 64 * j];
        for (int m = gw; m < M; m += 4 * NGW) {
            f32x4 v[4][4]; float rs[4];
#pragma unroll
            for (int rr = 0; rr < 4; ++rr) { const int mr = m + rr * NGW; if (mr < M) { const f32x4* xr = (const f32x4*)(out + (size_t)mr * D) + lane; rs[rr] = pg8::rstd_of(ssq4[mr]);
#pragma unroll
                for (int j = 0; j < 4; ++j) v[rr][j] = xr[64 * j]; } }
#pragma unroll
            for (int rr = 0; rr < 4; ++rr) { const int mr = m + rr * NGW; if (mr < M) { f32x4* xr = (f32x4*)(out + (size_t)mr * D) + lane;
#pragma unroll
                for (int j = 0; j < 4; ++j) xr[64 * j] = v[rr][j] * rs[rr] * gv[j]; } } } }
#undef IN
#undef SEAM
}

extern "C" void kernel_launch(void* const* d_in, const int* in_sizes, int n_in, void* d_out, int out_size, void* d_ws, size_t ws_size, hipStream_t stream) {
    static int grid = 0;
    if (grid == 0) {
        if (n_in != 16 || in_sizes[0] != M * D || out_size != M * D || ws_size < WS_END) { fprintf(stderr, "kernel_launch: unexpected shapes (n_in %d, in0 %d, out %d, ws %zu < %zu)\n", n_in, n_in > 0 ? in_sizes[0] : -1, out_size, ws_size, (size_t)WS_END); grid = -1; return; }
        int dev = 0, cus = 0, per_cu = 0;
        if (hipGetDevice(&dev) != hipSuccess || hipDeviceGetAttribute(&cus, hipDeviceAttributeMultiprocessorCount, dev) != hipSuccess) { grid = -1; return; }
        if (hipFuncSetAttribute((const void*)mk_fwd, hipFuncAttributeMaxDynamicSharedMemorySize, LDS_BYTES) != hipSuccess) { fprintf(stderr, "kernel_launch: hipFuncSetAttribute failed\n"); grid = -1; return; }
        if (hipOccupancyMaxActiveBlocksPerMultiprocessor(&per_cu, (const void*)mk_fwd, NTHR, LDS_BYTES) != hipSuccess || per_cu < 1) { fprintf(stderr, "kernel_launch: occupancy query gave %d\n", per_cu); (void)hipGetLastError(); per_cu = 1; }
        grid = cus * per_cu;
    }
    if (grid < 0) return;
    if (hipMemsetAsync((unsigned char*)d_ws + WS_BAR, 0, BAR_BYTES, stream) != hipSuccess) { fprintf(stderr, "kernel_launch: hipMemsetAsync failed\n"); return; }
    Args a{};
    for (int i = 0; i < 16; ++i) a.in[i] = (const float*)d_in[i];
    a.out = (float*)d_out; a.ws = (unsigned char*)d_ws;
    if (MK_N_LAUNCHES == 1) {
        a.ph_lo = 0; a.ph_hi = NPHASE;
        void* kargs[] = {&a};
        hipError_t e = hipLaunchCooperativeKernel((const void*)mk_fwd, dim3(grid), dim3(NTHR), kargs, LDS_BYTES, stream);
        if (e != hipSuccess) fprintf(stderr, "cooperative launch failed: %s (grid %d)\n", hipGetErrorString(e), grid);
    } else {
        for (int p = 0; p < NPHASE; ++p) { a.ph_lo = p; a.ph_hi = p + 1; hipLaunchKernelGGL(mk_fwd, dim3(grid), dim3(NTHR), LDS_BYTES, stream, a); }
    }
}
```
